# Optimizing an MI355X kernel written in HIP

```python
import math
import jax, jax.numpy as jnp
from jax import lax
import numpy as np

D_MODEL = 1024
BATCH = 2
SEQ = 16384
DEPTH = 2

EPS = 1e-6
MIX_DIM = D_MODEL
CONV_DIM = MIX_DIM // 2
CONV_GROUPS = 8
CONV_K = 3
LSTM_HEADS = 4
LSTM_DIM = MIX_DIM - CONV_DIM
LSTM_DH = LSTM_DIM // LSTM_HEADS
CHUNK = 128
OFF_XIN = 0
OFF_B = OFF_XIN + CONV_DIM
OFF_C = OFF_B + CONV_DIM
OFF_Q = OFF_C + CONV_DIM
OFF_K = OFF_Q + LSTM_DIM
OFF_V = OFF_K + LSTM_DIM
OFF_O = OFF_V + LSTM_DIM
OFF_IF = OFF_O + LSTM_DIM
IN_COLS = OFF_IF + 2 * LSTM_HEADS
N_MEM = 256
X_HEADS = 4
X_DH = D_MODEL // X_HEADS
P_HEADS = 8
N_KEYS = 128
N_EXPERTS = N_KEYS * N_KEYS
P_QDIM = 256
P_HALF = P_QDIM // 2
TOPK = 16
PEER_BLOCK = 128

kernel_name = 'hybrid_conv_mlstm_peer_block'


def rms_norm(x, g):
    xf = x.astype(jnp.float32)
    y = xf * lax.rsqrt(jnp.mean(xf * xf, axis=-1, keepdims=True) + EPS)
    return (y * g.astype(jnp.float32)).astype(x.dtype)


def mlstm_chunkwise(q, k, v, i_pre, f_pre):
    B, S, H, DH = q.shape
    NC = S // CHUNK
    f32 = jnp.float32

    def to_chunks(a):
        return a.astype(f32).reshape(B, NC, CHUNK, H, DH).transpose(1, 0, 3, 2, 4)

    def gate_chunks(a):
        return a.astype(f32).reshape(B, NC, CHUNK, H).transpose(1, 0, 3, 2)

    qc = to_chunks(q)
    kc = to_chunks(k) * (DH ** -0.5)
    vc = to_chunks(v)
    ig = gate_chunks(i_pre)
    bcum = jnp.cumsum(jax.nn.log_sigmoid(gate_chunks(f_pre)), axis=-1)
    mask = jnp.tril(jnp.ones((CHUNK, CHUNK), dtype=bool))

    def step(carry, inp):
        C, n, m = carry
        q_, k_, v_, i_, b_ = inp
        D = b_[..., :, None] - b_[..., None, :] + i_[..., None, :]
        D = jnp.where(mask, D, -jnp.inf)
        inter = b_ + m[..., None]
        m_t = jnp.maximum(inter, jnp.max(D, axis=-1))
        Dw = jnp.exp(D - m_t[..., None])
        iw = jnp.exp(inter - m_t)
        s = jnp.einsum('bhtd,bhsd->bhts', q_, k_) * Dw
        num = jnp.einsum('bhts,bhsv->bhtv', s, v_) + iw[..., None] * jnp.einsum('bhvk,bhtk->bhtv', C, q_)
        den = jnp.sum(s, axis=-1) + iw * jnp.einsum('bhtk,bhk->bht', q_, n)
        h = num / jnp.maximum(jnp.abs(den), jnp.exp(-m_t))[..., None]
        bL = b_[..., -1]
        gsum = bL[..., None] - b_ + i_
        m_new = jnp.maximum(bL + m, jnp.max(gsum, axis=-1))
        wdec = jnp.exp(bL + m - m_new)
        ws = jnp.exp(gsum - m_new[..., None])
        C_new = wdec[..., None, None] * C + jnp.einsum('bhsv,bhsk->bhvk', v_ * ws[..., None], k_)
        n_new = wdec[..., None] * n + jnp.einsum('bhs,bhsk->bhk', ws, k_)
        return (C_new, n_new, m_new), h

    init = (jnp.zeros((B, H, DH, DH), f32), jnp.zeros((B, H, DH), f32), jnp.zeros((B, H), f32))
    _, hs = lax.scan(step, init, (qc, kc, vc, ig, bcum))
    return hs.transpose(1, 0, 3, 2, 4).reshape(B, S, H, DH)


def hybrid_mixer(h, w_in, b_if, conv_w, conv_b, g_head, w_out):
    B, S, _ = h.shape
    z = h @ w_in
    xin = z[..., OFF_XIN:OFF_B]
    bg = z[..., OFF_B:OFF_C]
    cg = z[..., OFF_C:OFF_Q]
    q = z[..., OFF_Q:OFF_K].reshape(B, S, LSTM_HEADS, LSTM_DH)
    k = z[..., OFF_K:OFF_V].reshape(B, S, LSTM_HEADS, LSTM_DH)
    v = z[..., OFF_V:OFF_O].reshape(B, S, LSTM_HEADS, LSTM_DH)
    o = jax.nn.sigmoid(z[..., OFF_O:OFF_IF])
    gates = z[..., OFF_IF:] + b_if
    i_pre = gates[..., :LSTM_HEADS]
    f_pre = gates[..., LSTM_HEADS:]

    u = cg * xin
    c = lax.conv_general_dilated(u, conv_w[:, None, :], window_strides=(1,), padding=[(CONV_K - 1, 0)],
                                 dimension_numbers=('NWC', 'WIO', 'NWC'), feature_group_count=CONV_DIM)
    y_conv = bg * (c + conv_b)

    ht = mlstm_chunkwise(q, k, v, i_pre, f_pre).reshape(B, S, LSTM_DIM)
    hl = (o.astype(jnp.float32) * ht).reshape(B, S, LSTM_HEADS, LSTM_DH)
    hl = hl * lax.rsqrt(jnp.mean(hl * hl, axis=-1, keepdims=True) + EPS)
    y_lstm = (hl.reshape(B, S, LSTM_DIM) * g_head.astype(jnp.float32)).astype(h.dtype)

    return jnp.concatenate([y_conv, y_lstm], axis=-1) @ w_out


def memory_cross_attention(h, memn, w_xq, w_xk, w_xv, w_xo):
    B, S, _ = h.shape
    q = (h @ w_xq).reshape(B, S, X_HEADS, X_DH)
    k = (memn @ w_xk).reshape(B, N_MEM, X_HEADS, X_DH)
    v = (memn @ w_xv).reshape(B, N_MEM, X_HEADS, X_DH)
    s = jnp.einsum('bshd,bmhd->bhsm', q, k).astype(jnp.float32) * (X_DH ** -0.5)
    p = jax.nn.softmax(s, axis=-1).astype(h.dtype)
    out = jnp.einsum('bhsm,bmhd->bshd', p, v).reshape(B, S, D_MODEL)
    return out @ w_xo


def peer_ffn(h, w_pq, sub_keys, u_experts, v_experts):
    B, S, D = h.shape
    blocks = h.reshape(-1, PEER_BLOCK, D)

    def block(xb):
        q = (xb @ w_pq).reshape(PEER_BLOCK, P_HEADS, 2, P_HALF)
        sc = jnp.einsum('thpc,hpkc->thpk', q, sub_keys)
        sv, si = lax.top_k(sc, TOPK)
        cand = (sv[..., 0, :, None] + sv[..., 1, None, :]).reshape(PEER_BLOCK, P_HEADS, TOPK * TOPK)
        cid = (si[..., 0, :, None] * N_KEYS + si[..., 1, None, :]).reshape(PEER_BLOCK, P_HEADS, TOPK * TOPK)
        fv, fi = lax.top_k(cand, TOPK)
        eid = jnp.take_along_axis(cid, fi, axis=-1)
        g = jax.nn.softmax(fv.astype(jnp.float32), axis=-1).astype(xb.dtype)
        ue = jnp.take(u_experts, eid, axis=0)
        ve = jnp.take(v_experts, eid, axis=0)
        a = jax.nn.gelu(jnp.einsum('thkd,td->thk', ue, xb), approximate=False)
        return jnp.einsum('thk,thkd->td', g * a, ve)

    return lax.map(block, blocks).reshape(B, S, D)


def setup_inputs(seed: int = 0) -> dict:
    key = jax.random.key(seed)
    ks = jax.random.split(key, 24)

    def nrm(k, shape, scale):
        return jax.random.normal(k, shape, jnp.float32) * scale

    x = nrm(ks[0], (BATCH, SEQ, D_MODEL), 1.0)
    mem = nrm(ks[1], (BATCH, N_MEM, D_MODEL), 1.0)
    g_mix = 1.0 + nrm(ks[2], (DEPTH, D_MODEL), 0.02)
    w_in = nrm(ks[3], (DEPTH, D_MODEL, IN_COLS), D_MODEL ** -0.5)
    b_i = nrm(ks[4], (DEPTH, LSTM_HEADS), 0.1)
    b_f = 3.0 + nrm(ks[5], (DEPTH, LSTM_HEADS), 0.1)
    b_if = jnp.concatenate([b_i, b_f], axis=-1)
    conv_w = nrm(ks[6], (DEPTH, CONV_K, CONV_DIM), CONV_K ** -0.5)
    conv_b = nrm(ks[7], (DEPTH, CONV_DIM), 0.02)
    g_head = 1.0 + nrm(ks[8], (DEPTH, LSTM_DIM), 0.02)
    w_out = nrm(ks[9], (DEPTH, MIX_DIM, D_MODEL), MIX_DIM ** -0.5)
    g_xattn = 1.0 + nrm(ks[10], (DEPTH, D_MODEL), 0.02)
    g_mem = 1.0 + nrm(ks[11], (DEPTH, D_MODEL), 0.02)
    w_xq = nrm(ks[12], (DEPTH, D_MODEL, D_MODEL), D_MODEL ** -0.5)
    w_xk = nrm(ks[13], (DEPTH, D_MODEL, D_MODEL), D_MODEL ** -0.5)
    w_xv = nrm(ks[14], (DEPTH, D_MODEL, D_MODEL), D_MODEL ** -0.5)
    w_xo = nrm(ks[15], (DEPTH, D_MODEL, D_MODEL), D_MODEL ** -0.5)
    g_ffn = 1.0 + nrm(ks[16], (DEPTH, D_MODEL), 0.02)
    w_pq = nrm(ks[17], (DEPTH, D_MODEL, P_HEADS * P_QDIM), D_MODEL ** -0.5)
    sub_keys = nrm(ks[18], (DEPTH, P_HEADS, 2, N_KEYS, P_HALF), P_HALF ** -0.5)
    u_experts = nrm(ks[19], (DEPTH, N_EXPERTS, D_MODEL), D_MODEL ** -0.5)
    v_experts = nrm(ks[20], (DEPTH, N_EXPERTS, D_MODEL), 0.25)
    g_final = 1.0 + nrm(ks[21], (D_MODEL,), 0.02)
    return {'x': x, 'mem': mem, 'g_mix': g_mix, 'w_in': w_in, 'b_if': b_if, 'conv_w': conv_w,
            'conv_b': conv_b, 'g_head': g_head, 'w_out': w_out, 'g_xattn': g_xattn, 'g_mem': g_mem,
            'w_xq': w_xq, 'w_xk': w_xk, 'w_xv': w_xv, 'w_xo': w_xo, 'g_ffn': g_ffn, 'w_pq': w_pq,
            'sub_keys': sub_keys, 'u_experts': u_experts, 'v_experts': v_experts, 'g_final': g_final}


def reference(x, mem, g_mix, w_in, b_if, conv_w, conv_b, g_head, w_out, g_xattn, g_mem,
              w_xq, w_xk, w_xv, w_xo, g_ffn, w_pq, sub_keys, u_experts, v_experts, g_final):
    for l in range(DEPTH):
        h = rms_norm(x, g_mix[l])
        x = x + hybrid_mixer(h, w_in[l], b_if[l], conv_w[l], conv_b[l], g_head[l], w_out[l])
        h = rms_norm(x, g_xattn[l])
        x = x + memory_cross_attention(h, rms_norm(mem, g_mem[l]), w_xq[l], w_xk[l], w_xv[l], w_xo[l])
        h = rms_norm(x, g_ffn[l])
        x = x + peer_ffn(h, w_pq[l], sub_keys[l], u_experts[l], v_experts[l])
    return rms_norm(x, g_final)
```

```cpp
#include <hip/hip_runtime.h>
#include <hip/hip_cooperative_groups.h>
#include <cstdio>
#include <cstdint>
namespace cg = cooperative_groups;

typedef unsigned short u16;
typedef __attribute__((ext_vector_type(8))) __bf16 bf16x8;
typedef __attribute__((ext_vector_type(2))) __bf16 bf16x2;
typedef __attribute__((ext_vector_type(2))) float f32x2;
typedef __attribute__((ext_vector_type(16))) float f32x16;
typedef __attribute__((ext_vector_type(4))) unsigned int u32x4;
typedef __attribute__((ext_vector_type(2))) unsigned int u32x2;
typedef __attribute__((ext_vector_type(6))) unsigned int u32x6;
typedef __attribute__((ext_vector_type(3))) unsigned int u32x3;
typedef __attribute__((ext_vector_type(4))) float f32x4;
typedef __attribute__((ext_vector_type(32))) float f32x32;
typedef __attribute__((ext_vector_type(32))) __bf16 bf16x32;
typedef __attribute__((ext_vector_type(16))) unsigned int u32x16;

#define DEV __device__ __forceinline__
#define FP6_INTERLEAVED 1
#define GAS __attribute__((address_space(1)))

constexpr int DM = 1024;
constexpr int NTOK = 32768;
constexpr int NTILES = 256;
constexpr int NIN = 3584;
constexpr int NINP = 3616;
constexpr int NEXP = 16384;
constexpr int NT = 512;
constexpr float EPS = 1e-6f;

constexpr size_t MiB = 1024 * 1024;
constexpr size_t WS_WT_IN = 0;
constexpr size_t SZ_WT_IN1 = (size_t)NINP * 1024 * 2;
constexpr size_t WS_WT_OUT = WS_WT_IN + 2 * SZ_WT_IN1;
constexpr size_t WS_WT_XQ = WS_WT_OUT + 4 * MiB;
constexpr size_t WS_WT_XK = WS_WT_XQ + 4 * MiB;
constexpr size_t WS_WT_XV = WS_WT_XK + 4 * MiB;
constexpr size_t WS_WT_XO = WS_WT_XV + 4 * MiB;
constexpr size_t WS_WT_PQ = WS_WT_XO + 4 * MiB;
constexpr size_t WS_SKT = WS_WT_PQ + 8 * MiB;
constexpr size_t WS_MEMN = WS_SKT + 2 * MiB;
constexpr size_t WS_MEMK = WS_MEMN + 2 * MiB;
constexpr size_t WS_MEMVT = WS_MEMK + 2 * MiB;
constexpr size_t WS_GATES = WS_MEMVT + 2 * MiB;
constexpr size_t WS_BCUM = WS_GATES + 1 * MiB;
constexpr size_t WS_NLOC = WS_BCUM + 512 * 1024;
constexpr size_t WS_NSTATE = WS_NLOC + 512 * 1024;
constexpr size_t WS_MLOC = WS_NSTATE + 512 * 1024;
constexpr size_t WS_BL = WS_MLOC + 4096;
constexpr size_t WS_MSTATE = WS_BL + 4096;
constexpr size_t WS_HALO = WS_MSTATE + 4096;
constexpr size_t WS_Z = WS_HALO + 2 * MiB;
constexpr size_t WS_KT = WS_Z + (size_t)NTOK * NIN * 2;
constexpr size_t WS_VT = WS_KT + 32 * MiB;
constexpr size_t WS_KVLOC = WS_VT + 32 * MiB;
constexpr size_t WS_CSTATE = WS_KVLOC + 64 * MiB;
constexpr size_t WS_EXP6 = WS_CSTATE + 32 * MiB;
constexpr size_t WS_BAR = WS_EXP6 + 48 * MiB;
constexpr size_t WS_WT_MO = WS_BAR + 4096;
constexpr size_t WS_WT_MQ = WS_WT_MO + 8 * MiB;
constexpr size_t WS_END = WS_WT_MQ + 8 * MiB;

constexpr size_t ZSLOT = (size_t)128 * NIN * 2;
constexpr size_t R2_OFF = 0, R3_OFF = 256 * 1024, R4_OFF = 768 * 1024;

constexpr int LDS_BYTES = 131072 + 1024;

struct Params {
  const float *x, *mem, *g_mix, *w_in, *b_if, *conv_w, *conv_b, *g_head, *w_out, *g_xattn, *g_mem;
  const float *w_xq, *w_xk, *w_xv, *w_xo, *g_ffn, *w_pq, *sub_keys, *u_exp, *v_exp, *g_final;
  float* out;
  unsigned char* ws;
};

DEV int opaque_tid() { int t = threadIdx.x; asm volatile("" : "+v"(t)); return t; }
DEV unsigned char* opaque_ptr(unsigned char* q) { GAS unsigned char* g = (GAS unsigned char*)q; asm volatile("" : "+s"(g)); return (unsigned char*)g; }
DEV float bf2f(u16 v) { return __uint_as_float(((unsigned)v) << 16); }
DEV unsigned pk2(float lo, float hi) { f32x2 v = {lo, hi}; bf16x2 b = __builtin_convertvector(v, bf16x2); return __builtin_bit_cast(unsigned, b); }
DEV u16 f2bf(float f) { return (u16)(pk2(f, 0.f) & 0xffffu); }
template <int M> DEV float shx(float v) {
  if constexpr (M == 32) return __shfl_xor(v, 32);
  else return __builtin_bit_cast(float, __builtin_amdgcn_ds_swizzle(__builtin_bit_cast(int, v), (M << 10) | 0x1F));
}
DEV float shfl_idx(float v, int srclane) { return __builtin_bit_cast(float, __builtin_amdgcn_ds_bpermute(srclane << 2, __builtin_bit_cast(int, v))); }
DEV float wave_sum(float v) { v += shx<32>(v); v += shx<16>(v); v += shx<8>(v); v += shx<4>(v); v += shx<2>(v); v += shx<1>(v); return v; }
DEV float wave_max(float v) { v = fmaxf(v, shx<32>(v)); v = fmaxf(v, shx<16>(v)); v = fmaxf(v, shx<8>(v)); v = fmaxf(v, shx<4>(v)); v = fmaxf(v, shx<2>(v)); v = fmaxf(v, shx<1>(v)); return v; }
DEV __amdgpu_buffer_rsrc_t mkrsrc(const void* p) { return __builtin_amdgcn_make_buffer_rsrc((void*)p, 0, 0x7fffffff, 0x00020000); }
DEV int rowmap(int reg, int lane) { return (reg & 3) + 8 * (reg >> 2) + 4 * (lane >> 5); }
DEV f32x16 zero16() { f32x16 z;
#pragma unroll
  for (int i = 0; i < 16; ++i) z[i] = 0.f;
  return z; }
DEV bf16x8 ld_frag(const unsigned char* p) { return *(const bf16x8*)p; }
DEV bf16x8 ld_frag_g(const u16* p) { uint4 v = *(const uint4*)p; return __builtin_bit_cast(bf16x8, v); }
DEV float bflo(unsigned w) { return __uint_as_float(w << 16); }
DEV float bfhi(unsigned w) { return __uint_as_float(w & 0xffff0000u); }

DEV void rmsnorm_tile(const float* src, const float* g, u16* dst) {
  const int tid = opaque_tid(), wave = tid >> 6, lane = tid & 63;
  const float4* gr = (const float4*)g + lane;
  float4 gg[4];
#pragma unroll
  for (int j = 0; j < 4; ++j) gg[j] = gr[64 * j];
#pragma unroll 1
  for (int r0 = wave * 16; r0 < wave * 16 + 16; r0 += 4) {
    float4 v[4][4]; float ss[4];
#pragma unroll
    for (int q = 0; q < 4; ++q) {
      const float4* xr = (const float4*)(src + (size_t)(r0 + q) * DM) + lane;
#pragma unroll
      for (int j = 0; j < 4; ++j) v[q][j] = xr[64 * j];
    }
#pragma unroll
    for (int q = 0; q < 4; ++q) {
      float s = 0.f;
#pragma unroll
      for (int j = 0; j < 4; ++j) s += v[q][j].x * v[q][j].x + v[q][j].y * v[q][j].y + v[q][j].z * v[q][j].z + v[q][j].w * v[q][j].w;
      ss[q] = s;
    }
#pragma unroll
    for (int q = 0; q < 4; ++q) ss[q] = wave_sum(ss[q]);
#pragma unroll
    for (int q = 0; q < 4; ++q) {
      const float rs = rsqrtf(ss[q] * (1.f / DM) + EPS);
      uint2* o = (uint2*)(dst + (size_t)(r0 + q) * DM) + lane;
#pragma unroll
      for (int j = 0; j < 4; ++j) o[64 * j] = make_uint2(pk2(v[q][j].x * rs * gg[j].x, v[q][j].y * rs * gg[j].y), pk2(v[q][j].z * rs * gg[j].z, v[q][j].w * rs * gg[j].w));
    }
  }
}

struct TileDesc { const u16* A; int lda; const u16* B; int ldb; int kb; };
constexpr int G_STAGE = 55296, G_BOFF = 18432, G_PITCH = 144;

#define GEMM_LOAD(ra, rb, s_)                                                                                  \
  {                                                                                                            \
    const int j_ = (s_) / KS, kk_ = (s_) % KS;                                                                  \
    const TileDesc d_ = descf(j_);                                                                              \
    const __amdgpu_buffer_rsrc_t rsA_ = mkrsrc(d_.A), rsB_ = mkrsrc(d_.B);                                      \
    const int voA_ = ((tid >> 3) * d_.lda + (tid & 7) * 8) * 2, voB_ = ((tid >> 3) * d_.ldb + (tid & 7) * 8) * 2; \
    _Pragma("unroll") for (int i = 0; i < 2; ++i) ra[i] = __builtin_amdgcn_raw_buffer_load_b128(rsA_, voA_, (kk_ * 64 + i * 64 * d_.lda) * 2, 0); \
    _Pragma("unroll") for (int i = 0; i < 4; ++i) rb[i] = __builtin_amdgcn_raw_buffer_load_b128(rsB_, voB_, (kk_ * 64 + i * 64 * d_.ldb) * 2, 0); \
  }
#define GEMM_STORE(ra, rb, buf_)                                                                               \
  {                                                                                                            \
    unsigned char* base_ = lds + (buf_) * G_STAGE + (tid >> 3) * G_PITCH + (tid & 7) * 16;                      \
    _Pragma("unroll") for (int i = 0; i < 2; ++i) *(u32x4*)(base_ + i * 64 * G_PITCH) = ra[i];                  \
    _Pragma("unroll") for (int i = 0; i < 4; ++i) *(u32x4*)(base_ + G_BOFF + i * 64 * G_PITCH) = rb[i];         \
  }
#define GEMM_COMPUTE(buf_)                                                                                     \
  {                                                                                                            \
    const unsigned char* st = lds + (buf_) * G_STAGE;                                                           \
    _Pragma("unroll") for (int ks = 0; ks < 4; ++ks) {                                                          \
      const bf16x8 a0 = ld_frag(st + aoff + ks * 32), a1 = ld_frag(st + aoff + 32 * G_PITCH + ks * 32);         \
      const bf16x8 b0 = ld_frag(st + boff + ks * 32), b1 = ld_frag(st + boff + 32 * G_PITCH + ks * 32);         \
      acc[0][0] = __builtin_amdgcn_mfma_f32_32x32x16_bf16(a0, b0, acc[0][0], 0, 0, 0);                          \
      acc[0][1] = __builtin_amdgcn_mfma_f32_32x32x16_bf16(a0, b1, acc[0][1], 0, 0, 0);                          \
      acc[1][0] = __builtin_amdgcn_mfma_f32_32x32x16_bf16(a1, b0, acc[1][0], 0, 0, 0);                          \
      acc[1][1] = __builtin_amdgcn_mfma_f32_32x32x16_bf16(a1, b1, acc[1][1], 0, 0, 0);                          \
    }                                                                                                           \
  }
#define GEMM_EPI(s_)                                                                                           \
  if (((s_) % KS) == KS - 1) {                                                                                 \
    epif((s_) / KS, acc, wm, wn, lane);                                                                         \
    _Pragma("unroll") for (int a = 0; a < 2; ++a) _Pragma("unroll") for (int b = 0; b < 2; ++b) acc[a][b] = zero16(); \
  }

#define LC_LOAD(ra, rb, s_)                                                                                    \
  {                                                                                                            \
    const int j_ = (s_) / KS, kk_ = ((s_) + krot) % KS;                                                                  \
    const TileDesc d_ = descf(j_);                                                                              \
    const __amdgpu_buffer_rsrc_t rsA_ = mkrsrc(d_.A), rsB_ = mkrsrc(d_.B);                                      \
    const int voA_ = ((lt >> 3) * d_.lda + (lt & 7) * 8) * 2, voB_ = ((lt >> 3) * d_.ldb + (lt & 7) * 8) * 2;   \
    _Pragma("unroll") for (int i = 0; i < 4; ++i) ra[i] = __builtin_amdgcn_raw_buffer_load_b128(rsA_, voA_, (kk_ * 64 + ((i + rot) & 3) * 32 * d_.lda) * 2, 0); \
    _Pragma("unroll") for (int i = 0; i < 8; ++i) rb[i] = __builtin_amdgcn_raw_buffer_load_b128(rsB_, voB_, (kk_ * d_.kb + ((i + rot) & 7) * 32 * d_.ldb) * 2, 0); \
  }
#define LC_LOADC(ra, rb, s_) { const int sn_ = ((s_) < total) ? (s_) : total - 1; LC_LOAD(ra, rb, sn_); }
#define LC_STORE(ra, rb, buf_)                                                                                 \
  {                                                                                                            \
    unsigned char* base_ = lds + (buf_) * G_STAGE + (lt >> 3) * G_PITCH + (lt & 7) * 16;                        \
    _Pragma("unroll") for (int i = 0; i < 4; ++i) *(u32x4*)(base_ + ((i + rot) & 3) * 32 * G_PITCH) = ra[i];                  \
    _Pragma("unroll") for (int i = 0; i < 8; ++i) *(u32x4*)(base_ + G_BOFF + ((i + rot) & 7) * 32 * G_PITCH) = rb[i];         \
  }
#define LC_COMPUTE(buf_)                                                                                       \
  {                                                                                                            \
    const unsigned char* st = lds + (buf_) * G_STAGE;                                                           \
    _Pragma("unroll") for (int ks = 0; ks < 4; ++ks) {                                                          \
      const bf16x8 a0 = ld_frag(st + aoff + ks * 32), a1 = ld_frag(st + aoff + 32 * G_PITCH + ks * 32);         \
      _Pragma("unroll") for (int ni = 0; ni < 4; ++ni) {                                                        \
        const bf16x8 b = ld_frag(st + boff + ni * 32 * G_PITCH + ks * 32);                                      \
        if constexpr (SW) { acc[0][ni] = __builtin_amdgcn_mfma_f32_32x32x16_bf16(b, a0, acc[0][ni], 0, 0, 0); acc[1][ni] = __builtin_amdgcn_mfma_f32_32x32x16_bf16(b, a1, acc[1][ni], 0, 0, 0); } \
        else { acc[0][ni] = __builtin_amdgcn_mfma_f32_32x32x16_bf16(a0, b, acc[0][ni], 0, 0, 0); acc[1][ni] = __builtin_amdgcn_mfma_f32_32x32x16_bf16(a1, b, acc[1][ni], 0, 0, 0); } \
      }                                                                                                         \
    }                                                                                                           \
  }
#define LC_EPI(s_)                                                                                             \
  if (((s_) % KS) == KS - 1) {                                                                                 \
    epif((s_) / KS, acc, wm, wn, lane);                                                                         \
    _Pragma("unroll") for (int a = 0; a < 2; ++a) _Pragma("unroll") for (int b = 0; b < 4; ++b) acc[a][b] = zero16(); \
  }
#define LDS_BARRIER() do { asm volatile("s_waitcnt lgkmcnt(0)" ::: "memory"); __builtin_amdgcn_s_barrier(); asm volatile("" ::: "memory"); } while (0)

template <int KS, int EB = 0, bool SW = false, class DescF, class EpiF>
DEV void gemm_run(unsigned char* lds, int ntiles, DescF descf, EpiF epif) {
  const int tid = opaque_tid(), lane = tid & 63, wave = __builtin_amdgcn_readfirstlane(tid >> 6);
  const int total = ntiles * KS;
  __syncthreads();
  if (wave >= 4) {
    const int lt = tid - 256;
    const int krot = (9 * (__builtin_amdgcn_readfirstlane((int)blockIdx.x) >> 3) + 2 * (__builtin_amdgcn_readfirstlane((int)blockIdx.x) & 7)) & (KS - 1);
    const int rot = __builtin_amdgcn_readfirstlane((int)blockIdx.x) & 7;
    u32x4 ra0[4], rb0[8], ra1[4], rb1[8], ra2[4], rb2[8], ra3[4], rb3[8];
    LC_LOAD(ra0, rb0, 0);
    LC_LOAD(ra1, rb1, 1);
    LC_LOAD(ra2, rb2, 2);
    LC_LOAD(ra3, rb3, 3);
    LC_STORE(ra0, rb0, 0);
    LC_LOADC(ra0, rb0, 4);
    LDS_BARRIER();
#pragma unroll 1
    for (int s = 0; s < total; s += 4) {
#define LC_EB(s_) if (EB > 0 && ((s_) % KS) == KS - 1) { _Pragma("unroll") for (int eb = 0; eb < EB; ++eb) LDS_BARRIER(); }
      LC_STORE(ra1, rb1, 1); LC_LOADC(ra1, rb1, s + 5); LC_EB(s);     LDS_BARRIER();
      LC_STORE(ra2, rb2, 0); LC_LOADC(ra2, rb2, s + 6); LC_EB(s + 1); LDS_BARRIER();
      LC_STORE(ra3, rb3, 1); LC_LOADC(ra3, rb3, s + 7); LC_EB(s + 2); LDS_BARRIER();
      LC_STORE(ra0, rb0, 0); LC_LOADC(ra0, rb0, s + 8); LC_EB(s + 3); LDS_BARRIER();
#undef LC_EB
    }
  } else {
    const int wm = wave >> 1, wn = wave & 1;
    f32x16 acc[2][4];
#pragma unroll
    for (int a = 0; a < 2; ++a)
#pragma unroll
      for (int b = 0; b < 4; ++b) acc[a][b] = zero16();
    const int aoff = (wm * 64 + (lane & 31)) * G_PITCH + (lane >> 5) * 16;
    const int boff = G_BOFF + (wn * 128 + (lane & 31)) * G_PITCH + (lane >> 5) * 16;
    LDS_BARRIER();
    __builtin_amdgcn_s_setprio(2);
#pragma unroll 1
    for (int s = 0; s < total; s += 2) {
      LC_COMPUTE(0); LC_EPI(s);     LDS_BARRIER();
      LC_COMPUTE(1); LC_EPI(s + 1); LDS_BARRIER();
    }
    __builtin_amdgcn_s_setprio(0);
  }
  __syncthreads();
}

DEV void epi_store_bf16(const f32x16 (&acc)[2][4], int wm, int wn, int lane, u16* dst, int ld, int col0, float scale) {
  const __amdgpu_buffer_rsrc_t rs = mkrsrc(dst);
  const int voff = (4 * (lane >> 5) * ld + (lane & 31)) * 2;
#pragma unroll
  for (int mi = 0; mi < 2; ++mi)
#pragma unroll
    for (int ni = 0; ni < 4; ++ni)
#pragma unroll
      for (int r = 0; r < 16; ++r) {
        const int soff = ((wm * 64 + mi * 32 + (r & 3) + 8 * (r >> 2)) * ld + col0 + wn * 128 + ni * 32) * 2;
        __builtin_amdgcn_raw_buffer_store_b16(f2bf(acc[mi][ni][r] * scale), rs, voff, soff, 0);
      }
}
DEV void epi_store_u(const f32x16 (&acc)[2][4], int wm, int wn, int lane, u16* dst, int ld, int ucol0) {
  const __amdgpu_buffer_rsrc_t rs = mkrsrc(dst);
  const int voff = (4 * (lane >> 5) * ld + (lane & 31)) * 2;
#pragma unroll
  for (int mi = 0; mi < 2; ++mi)
#pragma unroll
    for (int pp = 0; pp < 2; ++pp)
#pragma unroll
      for (int r = 0; r < 16; ++r) {
        const int soff = ((wm * 64 + mi * 32 + (r & 3) + 8 * (r >> 2)) * ld + ucol0 + wn * 64 + pp * 32) * 2;
        __builtin_amdgcn_raw_buffer_store_b16(f2bf(acc[mi][2 * pp][r] * acc[mi][2 * pp + 1][r]), rs, voff, soff, 0);
      }
}
DEV void epi_store_f32(const f32x16 (&acc)[2][4], int wm, int wn, int lane, float* dst, int ld, int col0, float scale) {
  const __amdgpu_buffer_rsrc_t rs = mkrsrc(dst);
  const int voff = (4 * (lane >> 5) * ld + (lane & 31)) * 4;
#pragma unroll
  for (int mi = 0; mi < 2; ++mi)
#pragma unroll
    for (int ni = 0; ni < 4; ++ni)
#pragma unroll
      for (int r = 0; r < 16; ++r) {
        const int soff = ((wm * 64 + mi * 32 + (r & 3) + 8 * (r >> 2)) * ld + col0 + wn * 128 + ni * 32) * 4;
        __builtin_amdgcn_raw_buffer_store_b32(__float_as_uint(acc[mi][ni][r] * scale), rs, voff, soff, 0);
      }
}
DEV void epi_residual_norm(const f32x16 (&acc)[2][4], int wm, int wn, int lane, const void* src, bool src32, u16* dst, int col0, const float* g, u16* xg, float* rowss) {
  const __amdgpu_buffer_rsrc_t rsS = mkrsrc(src), rsD = mkrsrc(dst), rsX = mkrsrc(xg);
  const int voff = (4 * (lane >> 5) * DM + (lane & 31)) * 4;
  const int voffx = (4 * (lane >> 5) * DM + (lane & 31)) * 2;
#pragma unroll
  for (int mi = 0; mi < 2; ++mi) {
    float s[16];
#pragma unroll
    for (int ni = 0; ni < 4; ++ni) {
      float xv[16];
      const float gq = xg ? g[col0 + wn * 128 + ni * 32 + (lane & 31)] : 0.f;
      if (src32) {
#pragma unroll
        for (int r = 0; r < 16; ++r) {
          const int soff = ((wm * 64 + mi * 32 + (r & 3) + 8 * (r >> 2)) * DM + col0 + wn * 128 + ni * 32) * 4;
          xv[r] = __uint_as_float(__builtin_amdgcn_raw_buffer_load_b32(rsS, voff, soff, 0));
        }
      } else {
#pragma unroll
        for (int r = 0; r < 16; ++r) {
          const int soff = ((wm * 64 + mi * 32 + (r & 3) + 8 * (r >> 2)) * DM + col0 + wn * 128 + ni * 32) * 2;
          xv[r] = bf2f((u16)__builtin_amdgcn_raw_buffer_load_b16(rsS, voffx, soff, 0));
        }
      }
#pragma unroll
      for (int r = 0; r < 16; ++r) {
        const float v0 = xv[r] + acc[mi][ni][r];
        const int so = ((wm * 64 + mi * 32 + (r & 3) + 8 * (r >> 2)) * DM + col0 + wn * 128 + ni * 32);
        __builtin_amdgcn_raw_buffer_store_b16(f2bf(v0), rsD, voffx, so * 2, 0);
        if (xg) __builtin_amdgcn_raw_buffer_store_b16(f2bf(v0 * gq), rsX, voffx, so * 2, 0);
        s[r] = ni ? s[r] + v0 * v0 : v0 * v0;
      }
    }
    float t8[8], t4[4], t2[2], t1;
    const bool b4 = (lane & 16) != 0, b3 = (lane & 8) != 0, b2 = (lane & 4) != 0, b1 = (lane & 2) != 0;
#pragma unroll
    for (int q = 0; q < 8; ++q) { const float snd = b4 ? s[q] : s[q + 8], kp = b4 ? s[q + 8] : s[q]; t8[q] = kp + shx<16>(snd); }
#pragma unroll
    for (int q = 0; q < 4; ++q) { const float snd = b3 ? t8[q] : t8[q + 4], kp = b3 ? t8[q + 4] : t8[q]; t4[q] = kp + shx<8>(snd); }
#pragma unroll
    for (int q = 0; q < 2; ++q) { const float snd = b2 ? t4[q] : t4[q + 2], kp = b2 ? t4[q + 2] : t4[q]; t2[q] = kp + shx<4>(snd); }
    { const float snd = b1 ? t2[0] : t2[1], kp = b1 ? t2[1] : t2[0]; t1 = kp + shx<2>(snd); }
    t1 += shx<1>(t1);
    if ((lane & 1) == 0) {
      const int r = (lane >> 1) & 15;
      rowss[((col0 >> 8) * 2 + wn) * 128 + wm * 64 + mi * 32 + (r & 3) + 8 * (r >> 2) + 4 * (lane >> 5)] = t1;
    }
  }
}
DEV void epi_store_bf16_rows(const f32x16 (&acc)[2][4], int wm, int wn, int lane, u16* dst, int ld, int col0, const float* rsv) {
  const __amdgpu_buffer_rsrc_t rs = mkrsrc(dst);
  const int voff = (4 * (lane >> 5) * ld + (lane & 31)) * 2;
#pragma unroll
  for (int mi = 0; mi < 2; ++mi)
#pragma unroll
    for (int g = 0; g < 4; ++g) {
      const float4 sc4 = *(const float4*)(rsv + wm * 64 + mi * 32 + 8 * g + 4 * (lane >> 5));
      const float sc[4] = {sc4.x, sc4.y, sc4.z, sc4.w};
#pragma unroll
      for (int ni = 0; ni < 4; ++ni)
#pragma unroll
        for (int e = 0; e < 4; ++e) {
          const int soff = ((wm * 64 + mi * 32 + 8 * g + e) * ld + col0 + wn * 128 + ni * 32) * 2;
          __builtin_amdgcn_raw_buffer_store_b16(f2bf(acc[mi][ni][4 * g + e] * sc[e]), rs, voff, soff, 0);
        }
    }
}
DEV void epi_store_f32_rows(const f32x16 (&acc)[2][4], int wm, int wn, int lane, float* dst, int ld, int col0, const float* rsv) {
  const __amdgpu_buffer_rsrc_t rs = mkrsrc(dst);
  const int voff = (4 * (lane >> 5) * ld + (lane & 31)) * 4;
#pragma unroll
  for (int mi = 0; mi < 2; ++mi)
#pragma unroll
    for (int g = 0; g < 4; ++g) {
      const float4 sc4 = *(const float4*)(rsv + wm * 64 + mi * 32 + 8 * g + 4 * (lane >> 5));
      const float sc[4] = {sc4.x, sc4.y, sc4.z, sc4.w};
#pragma unroll
      for (int ni = 0; ni < 4; ++ni)
#pragma unroll
        for (int e = 0; e < 4; ++e) {
          const int soff = ((wm * 64 + mi * 32 + 8 * g + e) * ld + col0 + wn * 128 + ni * 32) * 4;
          __builtin_amdgcn_raw_buffer_store_b32(__float_as_uint(acc[mi][ni][4 * g + e] * sc[e]), rs, voff, soff, 0);
        }
    }
}
DEV void epi_store_bf16_T(const f32x16 (&acc)[2][4], int wm, int wn, int lane, u16* dst, int ldt, int colbase) {
  const __amdgpu_buffer_rsrc_t rs = mkrsrc(dst);
  const int voff = ((lane & 31) * ldt + 4 * (lane >> 5)) * 2;
#pragma unroll
  for (int mi = 0; mi < 2; ++mi)
#pragma unroll
    for (int ni = 0; ni < 4; ++ni)
#pragma unroll
      for (int g = 0; g < 4; ++g) {
        const int soff = ((colbase + wn * 128 + ni * 32) * ldt + wm * 64 + mi * 32 + 8 * g) * 2;
        u32x2 v; v.x = pk2(acc[mi][ni][4 * g], acc[mi][ni][4 * g + 1]); v.y = pk2(acc[mi][ni][4 * g + 2], acc[mi][ni][4 * g + 3]);
        __builtin_amdgcn_raw_buffer_store_b64(v, rs, voff, soff, 0);
      }
}

DEV void epi_store_tiled(const f32x16 (&acc)[2][4], int wm, int wn, int lane, u16* dst, int jn, int nbase, int kcol0, float scale) {
  const __amdgpu_buffer_rsrc_t rs = mkrsrc(dst);
  const int voff = (4 * (lane >> 5) * 64 + (lane & 31)) * 2;
#pragma unroll
  for (int mi = 0; mi < 2; ++mi)
#pragma unroll
    for (int ni = 0; ni < 4; ++ni)
#pragma unroll
      for (int r = 0; r < 16; ++r) {
        const int kc = kcol0 + wn * 128 + ni * 32;
        const int soff = ((jn * 16 + (kc >> 6)) * 16384 + (nbase + wm * 64 + mi * 32 + (r & 3) + 8 * (r >> 2)) * 64 + (kc & 63)) * 2;
        __builtin_amdgcn_raw_buffer_store_b16(f2bf(acc[mi][ni][r] * scale), rs, voff, soff, 0);
      }
}
DEV void epi_store_tiledT(const f32x16 (&acc)[2][4], int wm, int wn, int lane, u16* dst, int jn, int kbase) {
  const __amdgpu_buffer_rsrc_t rs = mkrsrc(dst);
  const int voff = ((lane & 31) * 64 + 4 * (lane >> 5)) * 2;
#pragma unroll
  for (int mi = 0; mi < 2; ++mi)
#pragma unroll
    for (int ni = 0; ni < 4; ++ni)
#pragma unroll
      for (int g = 0; g < 4; ++g) {
        const int k0 = kbase + wm * 64 + mi * 32 + 8 * g;
        const int soff = ((jn * 16 + (k0 >> 6)) * 16384 + (wn * 128 + ni * 32) * 64 + (k0 & 63)) * 2;
        u32x2 v; v.x = pk2(acc[mi][ni][4 * g], acc[mi][ni][4 * g + 1]); v.y = pk2(acc[mi][ni][4 * g + 2], acc[mi][ni][4 * g + 3]);
        __builtin_amdgcn_raw_buffer_store_b64(v, rs, voff, soff, 0);
      }
}

DEV void epi_softmax_bf16(const f32x16 (&acc)[2][4], int wm, int wn, int lane, u16* dst, int ld, int col0, const float* rsv, float* pm, float* ps) {
  const bool b4 = (lane & 16) != 0, b3 = (lane & 8) != 0, b2 = (lane & 4) != 0, b1 = (lane & 2) != 0;
  const int rsel = (lane >> 1) & 15;
  const int rrow = (rsel & 3) + 8 * (rsel >> 2) + 4 * (lane >> 5);
  float rsf[2][16];
#pragma unroll
  for (int mi = 0; mi < 2; ++mi)
#pragma unroll
    for (int g = 0; g < 4; ++g) {
      const float4 s4 = *(const float4*)(rsv + wm * 64 + mi * 32 + 8 * g + 4 * (lane >> 5));
      rsf[mi][4 * g] = s4.x; rsf[mi][4 * g + 1] = s4.y; rsf[mi][4 * g + 2] = s4.z; rsf[mi][4 * g + 3] = s4.w;
    }
#pragma unroll
  for (int mi = 0; mi < 2; ++mi) {
    float s[16];
#pragma unroll
    for (int r = 0; r < 16; ++r) s[r] = fmaxf(fmaxf(acc[mi][0][r], acc[mi][1][r]), fmaxf(acc[mi][2][r], acc[mi][3][r])) * rsf[mi][r];
    float t8[8], t4[4], t2[2], t1;
#pragma unroll
    for (int q = 0; q < 8; ++q) { const float snd = b4 ? s[q] : s[q + 8], kp = b4 ? s[q + 8] : s[q]; t8[q] = fmaxf(kp, shx<16>(snd)); }
#pragma unroll
    for (int q = 0; q < 4; ++q) { const float snd = b3 ? t8[q] : t8[q + 4], kp = b3 ? t8[q + 4] : t8[q]; t4[q] = fmaxf(kp, shx<8>(snd)); }
#pragma unroll
    for (int q = 0; q < 2; ++q) { const float snd = b2 ? t4[q] : t4[q + 2], kp = b2 ? t4[q + 2] : t4[q]; t2[q] = fmaxf(kp, shx<4>(snd)); }
    { const float snd = b1 ? t2[0] : t2[1], kp = b1 ? t2[1] : t2[0]; t1 = fmaxf(kp, shx<2>(snd)); }
    t1 = fmaxf(t1, shx<1>(t1));
    if ((lane & 1) == 0) pm[wn * 128 + wm * 64 + mi * 32 + rrow] = t1;
  }
  LDS_BARRIER();
#pragma unroll
  for (int mi = 0; mi < 2; ++mi) {
    float s[16];
#pragma unroll
    for (int g = 0; g < 4; ++g) {
      const int rb = wm * 64 + mi * 32 + 8 * g + 4 * (lane >> 5);
      const float4 m0 = *(const float4*)(pm + rb), m1 = *(const float4*)(pm + 128 + rb);
      const float mx[4] = {fmaxf(m0.x, m1.x), fmaxf(m0.y, m1.y), fmaxf(m0.z, m1.z), fmaxf(m0.w, m1.w)};
#pragma unroll
      for (int q = 0; q < 4; ++q) {
        float e = 0.f;
#pragma unroll
        for (int ni = 0; ni < 4; ++ni) e += __expf(acc[mi][ni][4 * g + q] * rsf[mi][4 * g + q] - mx[q]);
        s[4 * g + q] = e;
      }
    }
    float t8[8], t4[4], t2[2], t1;
#pragma unroll
    for (int q = 0; q < 8; ++q) { const float snd = b4 ? s[q] : s[q + 8], kp = b4 ? s[q + 8] : s[q]; t8[q] = kp + shx<16>(snd); }
#pragma unroll
    for (int q = 0; q < 4; ++q) { const float snd = b3 ? t8[q] : t8[q + 4], kp = b3 ? t8[q + 4] : t8[q]; t4[q] = kp + shx<8>(snd); }
#pragma unroll
    for (int q = 0; q < 2; ++q) { const float snd = b2 ? t4[q] : t4[q + 2], kp = b2 ? t4[q + 2] : t4[q]; t2[q] = kp + shx<4>(snd); }
    { const float snd = b1 ? t2[0] : t2[1], kp = b1 ? t2[1] : t2[0]; t1 = kp + shx<2>(snd); }
    t1 += shx<1>(t1);
    if ((lane & 1) == 0) ps[wn * 128 + wm * 64 + mi * 32 + rrow] = t1;
  }
  LDS_BARRIER();
  const __amdgpu_buffer_rsrc_t rs = mkrsrc(dst);
  const int voff = (4 * (lane >> 5) * ld + (lane & 31)) * 2;
#pragma unroll
  for (int mi = 0; mi < 2; ++mi)
#pragma unroll
    for (int g = 0; g < 4; ++g) {
      const int rb = wm * 64 + mi * 32 + 8 * g + 4 * (lane >> 5);
      const float4 m0 = *(const float4*)(pm + rb), m1 = *(const float4*)(pm + 128 + rb);
      const float mx[4] = {fmaxf(m0.x, m1.x), fmaxf(m0.y, m1.y), fmaxf(m0.z, m1.z), fmaxf(m0.w, m1.w)};
      const float4 s0 = *(const float4*)(ps + rb), s1 = *(const float4*)(ps + 128 + rb);
      const float inv[4] = {1.f / (s0.x + s1.x), 1.f / (s0.y + s1.y), 1.f / (s0.z + s1.z), 1.f / (s0.w + s1.w)};
#pragma unroll
      for (int ni = 0; ni < 4; ++ni)
#pragma unroll
        for (int q = 0; q < 4; ++q) {
          const int soff = ((wm * 64 + mi * 32 + 8 * g + q) * ld + col0 + wn * 128 + ni * 32) * 2;
          __builtin_amdgcn_raw_buffer_store_b16(f2bf(__expf(acc[mi][ni][4 * g + q] * rsf[mi][4 * g + q] - mx[q]) * inv[q]), rs, voff, soff, 0);
        }
    }
  LDS_BARRIER();
}

DEV void transpose_item(const float* W, int N, u16* WT, float* scr, int item, int nblk, int lane, bool inmap = false) {
  const int kb = item / nblk, nb = item % nblk, k0 = 64 * kb, n0 = 32 * nb;
  int ns = n0;
  if (inmap) {
    if (nb < 32) { const int q = nb & 7, c0 = (nb >> 3) * 128 + (q >> 2) * 64 + ((q & 3) >> 1) * 32; ns = (q & 1) ? 1024 + c0 : c0; }
    else if (nb < 48) ns = 512 + (nb - 32) * 32;
  }
  const int kq = lane >> 3, nq = (lane & 7) * 4;
  float4 v[8];
#pragma unroll
  for (int i = 0; i < 8; ++i) v[i] = (ns + nq < N) ? *(const float4*)(W + (size_t)(k0 + 8 * i + kq) * N + ns + nq) : make_float4(0.f, 0.f, 0.f, 0.f);
#pragma unroll
  for (int i = 0; i < 8; ++i) { float* d = scr + (8 * i + kq) * 33 + nq; d[0] = v[i].x; d[1] = v[i].y; d[2] = v[i].z; d[3] = v[i].w; }
  const int c = lane & 7;
#pragma unroll
  for (int j = 0; j < 4; ++j) {
    const int nn = (lane >> 3) + 8 * j; const float* s = scr + (8 * c) * 33 + nn;
    uint4 o; o.x = pk2(s[0 * 33], s[1 * 33]); o.y = pk2(s[2 * 33], s[3 * 33]); o.z = pk2(s[4 * 33], s[5 * 33]); o.w = pk2(s[6 * 33], s[7 * 33]);
    const int n = n0 + nn;
    const size_t off = (n < (N & ~255)) ? ((size_t)((n >> 8) * 16 + (k0 >> 6)) * 16384 + (size_t)(n & 255) * 64 + 8 * c) : ((size_t)n * 1024 + k0 + 8 * c);
    *(uint4*)(WT + off) = o;
  }
}

DEV void fold_item(const float* W, const float* SK, u16* WT, float* scr, int item, int lane) {
  const int kb = item >> 6, nb = item & 63, k0 = 64 * kb, n0 = 32 * nb;
  const int kq = lane >> 3, nq = (lane & 7) * 4;
  const int blk = n0 >> 7, key0 = (n0 & 127) + nq;
  const float* wp = W + (size_t)(k0 + kq) * 2048 + blk * 128;
  const float* sp = SK + ((size_t)blk * 128 + key0) * 128;
  float o[8][4];
#pragma unroll
  for (int i = 0; i < 8; ++i)
#pragma unroll
    for (int e = 0; e < 4; ++e) o[i][e] = 0.f;
#pragma unroll 2
  for (int c4 = 0; c4 < 32; ++c4) {
    float4 wv[8], sv[4];
#pragma unroll
    for (int i = 0; i < 8; ++i) wv[i] = *(const float4*)(wp + (size_t)(8 * i) * 2048 + 4 * c4);
#pragma unroll
    for (int e = 0; e < 4; ++e) sv[e] = *(const float4*)(sp + e * 128 + 4 * c4);
#pragma unroll
    for (int i = 0; i < 8; ++i)
#pragma unroll
      for (int e = 0; e < 4; ++e) o[i][e] += (wv[i].x * sv[e].x + wv[i].y * sv[e].y) + (wv[i].z * sv[e].z + wv[i].w * sv[e].w);
  }
#pragma unroll
  for (int i = 0; i < 8; ++i) { float* d = scr + (8 * i + kq) * 33 + nq; d[0] = o[i][0]; d[1] = o[i][1]; d[2] = o[i][2]; d[3] = o[i][3]; }
  const int c = lane & 7;
#pragma unroll
  for (int j = 0; j < 4; ++j) {
    const int nn = (lane >> 3) + 8 * j; const float* s = scr + (8 * c) * 33 + nn;
    uint4 ov; ov.x = pk2(s[0 * 33], s[1 * 33]); ov.y = pk2(s[2 * 33], s[3 * 33]); ov.z = pk2(s[4 * 33], s[5 * 33]); ov.w = pk2(s[6 * 33], s[7 * 33]);
    const int n = n0 + nn;
    *(uint4*)(WT + (size_t)((n >> 8) * 16 + kb) * 16384 + (size_t)(n & 255) * 64 + 8 * c) = ov;
  }
}

DEV void phase0(const Params& p, unsigned char* lds) {
  const int tid = opaque_tid(), lane = tid & 63, wave = tid >> 6;
  const int gw = blockIdx.x * 8 + wave, NGW = gridDim.x * 8;
  float* scr = (float*)(lds + wave * 8704);
  unsigned char* ws = p.ws;
  constexpr int I_IN = 16 * 113, I_SQ = 16 * 32, I_PQ = 16 * 64;
  constexpr int IPL = I_IN + 5 * I_SQ + I_PQ;
  for (int it = gw; it < 2 * IPL; it += NGW) {
    const int l = it / IPL; int r = it % IPL;
    if (r < I_IN) { transpose_item(p.w_in + (size_t)l * 1024 * 3592, 3592, (u16*)(ws + WS_WT_IN + l * SZ_WT_IN1), scr, r, 113, lane, true); continue; } r -= I_IN;
    if (r < I_SQ) { transpose_item(p.w_out + (size_t)l * DM * DM, 1024, (u16*)(ws + WS_WT_OUT + l * 2 * MiB), scr, r, 32, lane); continue; } r -= I_SQ;
    if (r < I_SQ) {
      const float4* s4 = (const float4*)(p.w_xq + (size_t)l * DM * DM) + (size_t)r * 512 + lane;
      uint2* d2 = (uint2*)(ws + WS_WT_XQ + l * 2 * MiB) + (size_t)r * 512 + lane;
#pragma unroll
      for (int i = 0; i < 8; ++i) { const float gk = p.g_xattn[l * DM + 2 * r + (i >> 2)];
        const float4 f = s4[64 * i]; d2[64 * i] = make_uint2(pk2(f.x * gk, f.y * gk), pk2(f.z * gk, f.w * gk)); }
      continue; } r -= I_SQ;
    if (r < I_SQ) { transpose_item(p.w_xk + (size_t)l * DM * DM, 1024, (u16*)(ws + WS_WT_XK + l * 2 * MiB), scr, r, 32, lane); continue; } r -= I_SQ;
    if (r < I_SQ) { transpose_item(p.w_xv + (size_t)l * DM * DM, 1024, (u16*)(ws + WS_WT_XV + l * 2 * MiB), scr, r, 32, lane); continue; } r -= I_SQ;
    if (r < I_SQ) { transpose_item(p.w_xo + (size_t)l * DM * DM, 1024, (u16*)(ws + WS_WT_XO + l * 2 * MiB), scr, r, 32, lane); continue; } r -= I_SQ;
    fold_item(p.w_pq + (size_t)l * DM * 2048, p.sub_keys + (size_t)l * 16 * 128 * 128, (u16*)(ws + WS_WT_PQ + l * 4 * MiB), scr, r, lane);
  }
  {
    unsigned char* e6 = ws + WS_EXP6;
    const int hl = lane & 31, q = hl & 15, c0 = 2 * (hl >> 4);
    for (int rp = gw; rp < 2 * NEXP; rp += NGW) {
      const int row = rp * 2 + (lane >> 5);
      const int l = row >> 15, uv = (row >> 14) & 1, e = row & (NEXP - 1);
      const float* srcp = (uv ? p.v_exp : p.u_exp) + ((size_t)l * NEXP + e) * DM;
      const float scl = uv ? 6.f : 48.f;
      f32x16 fa, fb;
#pragma unroll
      for (int j = 0; j < 8; ++j) {
        float4 f = ((const float4*)srcp)[64 * (c0 + (j >> 2)) + q + 16 * (j & 3)];
        f.x = fminf(fmaxf(f.x * scl, -7.5f), 7.5f); f.y = fminf(fmaxf(f.y * scl, -7.5f), 7.5f);
        f.z = fminf(fmaxf(f.z * scl, -7.5f), 7.5f); f.w = fminf(fmaxf(f.w * scl, -7.5f), 7.5f);
        fa[2 * j] = f.x; fb[2 * j] = f.y; fa[2 * j + 1] = f.z; fb[2 * j + 1] = f.w;
      }
      const u32x6 o = __builtin_amdgcn_cvt_scalef32_2xpk16_fp6_f32(fa, fb, 1.0f);
      unsigned char* dst = e6 + (size_t)(l * 2 + uv) * NEXP * 768 + ((size_t)c0 * NEXP + e) * 192 + q * 12;
      *(unsigned*)(dst) = o[0]; *(unsigned*)(dst + 4) = o[1]; *(unsigned*)(dst + 8) = o[2];
      dst += (size_t)NEXP * 192;
      *(unsigned*)(dst) = o[3]; *(unsigned*)(dst + 4) = o[4]; *(unsigned*)(dst + 8) = o[5];
    }
  }
  for (int row = gw; row < 1024; row += NGW) {
    const int l = row >> 9, r = row & 511;
    const float4* xr = (const float4*)(p.mem + (size_t)r * DM) + lane;
    float4 v[4]; float ss = 0.f;
#pragma unroll
    for (int j = 0; j < 4; ++j) { v[j] = xr[64 * j]; ss += v[j].x * v[j].x + v[j].y * v[j].y + v[j].z * v[j].z + v[j].w * v[j].w; }
    ss = wave_sum(ss);
    const float rs = rsqrtf(ss * (1.f / DM) + EPS);
    const float4* gr = (const float4*)(p.g_mem + l * DM) + lane;
    uint2* o = (uint2*)((u16*)(ws + WS_MEMN) + (size_t)row * DM) + lane;
#pragma unroll
    for (int j = 0; j < 4; ++j) { float4 gg = gr[64 * j]; o[64 * j] = make_uint2(pk2(v[j].x * rs * gg.x, v[j].y * rs * gg.y), pk2(v[j].z * rs * gg.z, v[j].w * rs * gg.w)); }
  }
}

DEV void memkv_job(const Params& p, unsigned char* lds, int job) {
  unsigned char* ws = opaque_ptr(p.ws);
  const int l = job >> 5, kv = (job >> 4) & 1, rt = (job >> 2) & 3, nt = job & 3;
  const u16* A = (const u16*)(ws + WS_MEMN) + ((size_t)l * 512 + rt * 128) * DM;
  const u16* B = (const u16*)(ws + (kv ? WS_WT_XV : WS_WT_XK) + l * 2 * MiB) + (size_t)nt * 256 * DM;
  u16* memk = (u16*)(ws + WS_MEMK) + ((size_t)l * 512 + rt * 128) * DM;
  u16* memv = (u16*)(ws + WS_MEMVT) + ((size_t)l * 512 + rt * 128) * DM;
  gemm_run<16>(lds, 1,
    [=](int) { TileDesc d; d.A = A; d.lda = DM; d.B = B; d.ldb = 64; d.kb = 16384; return d; },
    [=](int, const f32x16 (&acc)[2][4], int wm, int wn, int lane) { epi_store_bf16(acc, wm, wn, lane, kv ? memv : memk, DM, nt * 256, 1.f); });
}

DEV void foldq_job(const Params& p, unsigned char* lds, int job) {
  unsigned char* ws = opaque_ptr(p.ws);
  const int l = job >> 5, b = (job >> 4) & 1, h = (job >> 2) & 3, mt = (job >> 1) & 1, kh = job & 1;
  const u16* A = (const u16*)(ws + WS_MEMK) + ((size_t)l * 512 + b * 256 + mt * 128) * DM + h * 256;
  const u16* wq = (const u16*)(ws + WS_WT_XQ + l * 2 * MiB) + h * 256;
  u16* mq = (u16*)(ws + WS_WT_MQ) + (size_t)(l * 2 + b) * 1024 * 1024;
  gemm_run<4>(lds, 2,
    [=](int j) { TileDesc d; d.A = A; d.lda = DM; d.B = wq + (size_t)(kh * 2 + j) * 256 * DM; d.ldb = DM; d.kb = 64; return d; },
    [=](int j, const f32x16 (&acc)[2][4], int wm, int wn, int lane) { epi_store_tiled(acc, wm, wn, lane, mq, h, mt * 128, (kh * 2 + j) * 256, 0.0625f); });
}

DEV void foldv_job(const Params& p, unsigned char* lds, int job) {
  unsigned char* ws = opaque_ptr(p.ws);
  const int l = job >> 5, b = (job >> 4) & 1, h = (job >> 2) & 3, mt = (job >> 1) & 1, nh = job & 1;
  const u16* A = (const u16*)(ws + WS_MEMVT) + ((size_t)l * 512 + b * 256 + mt * 128) * DM + h * 256;
  const u16* wt = (const u16*)(ws + WS_WT_XO + l * 2 * MiB) + (size_t)(4 * h) * 16384;
  u16* mo = (u16*)(ws + WS_WT_MO) + (size_t)(l * 2 + b) * 1024 * 1024;
  gemm_run<4>(lds, 2,
    [=](int j) { TileDesc d; d.A = A; d.lda = DM; d.B = wt + (size_t)(nh * 2 + j) * 256 * DM; d.ldb = 64; d.kb = 16384; return d; },
    [=](int j, const f32x16 (&acc)[2][4], int wm, int wn, int lane) { epi_store_tiledT(acc, wm, wn, lane, mo, nh * 2 + j, h * 256 + mt * 128); });
}

constexpr int P272 = 272;
DEV void stage_rows256(unsigned char* dst, const u16* src, int stride_elems) {
  const int tid = opaque_tid();
  const int row = tid >> 4, cc = tid & 15;
  const u16* p0 = src + (size_t)row * stride_elems + cc * 8;
  const uint4 a0 = *(const uint4*)(p0), a1 = *(const uint4*)(p0 + (size_t)32 * stride_elems), a2 = *(const uint4*)(p0 + (size_t)64 * stride_elems), a3 = *(const uint4*)(p0 + (size_t)96 * stride_elems);
  const int o = row * P272 + cc * 16;
  *(uint4*)(dst + o) = a0; *(uint4*)(dst + o + 32 * P272) = a1; *(uint4*)(dst + o + 64 * P272) = a2; *(uint4*)(dst + o + 96 * P272) = a3;
}
DEV void stage_rows256x3(unsigned char* d0, const u16* s0, int st0, unsigned char* d1, const u16* s1, int st1, unsigned char* d2, const u16* s2, int st2) {
  const int tid = opaque_tid();
  const int row = tid >> 4, cc = tid & 15;
  const u16* p0 = s0 + (size_t)row * st0 + cc * 8; const u16* p1 = s1 + (size_t)row * st1 + cc * 8; const u16* p2 = s2 + (size_t)row * st2 + cc * 8;
  const uint4 a0 = *(const uint4*)(p0), a1 = *(const uint4*)(p0 + (size_t)32 * st0), a2 = *(const uint4*)(p0 + (size_t)64 * st0), a3 = *(const uint4*)(p0 + (size_t)96 * st0);
  const uint4 b0 = *(const uint4*)(p1), b1 = *(const uint4*)(p1 + (size_t)32 * st1), b2 = *(const uint4*)(p1 + (size_t)64 * st1), b3 = *(const uint4*)(p1 + (size_t)96 * st1);
  const uint4 c0 = *(const uint4*)(p2), c1 = *(const uint4*)(p2 + (size_t)32 * st2), c2 = *(const uint4*)(p2 + (size_t)64 * st2), c3 = *(const uint4*)(p2 + (size_t)96 * st2);
  const int o = row * P272 + cc * 16;
  *(uint4*)(d0 + o) = a0; *(uint4*)(d0 + o + 32 * P272) = a1; *(uint4*)(d0 + o + 64 * P272) = a2; *(uint4*)(d0 + o + 96 * P272) = a3;
  *(uint4*)(d1 + o) = b0; *(uint4*)(d1 + o + 32 * P272) = b1; *(uint4*)(d1 + o + 64 * P272) = b2; *(uint4*)(d1 + o + 96 * P272) = b3;
  *(uint4*)(d2 + o) = c0; *(uint4*)(d2 + o + 32 * P272) = c1; *(uint4*)(d2 + o + 64 * P272) = c2; *(uint4*)(d2 + o + 96 * P272) = c3;
}

DEV void phaseA_tile(const Params& p, unsigned char* lds, int l_in, int tile_in) {
  int l = __builtin_amdgcn_readfirstlane(l_in), tile = __builtin_amdgcn_readfirstlane(tile_in);
  asm volatile("" : "+s"(l), "+s"(tile));
  unsigned char* ws = opaque_ptr(p.ws);
  const int tid = opaque_tid(), lane = tid & 63, wave = tid >> 6;
  const u16* hbuf = (const u16*)(ws + WS_KVLOC + (size_t)tile * 256 * 1024);
  u16* z = (u16*)(ws + WS_Z) + (size_t)tile * 128 * NIN;
  u16* kT = (u16*)(ws + WS_KT) + (size_t)tile * 4 * 16384;
  u16* vT = (u16*)(ws + WS_VT) + (size_t)tile * 4 * 16384;
  const u16* wt_in = (const u16*)(ws + WS_WT_IN + l * SZ_WT_IN1);
  float* gates = (float*)(ws + WS_GATES) + (size_t)tile * 128 * 8;

  gemm_run<16>(lds, 14,
    [=](int j) { TileDesc d; d.A = hbuf; d.lda = DM; d.B = wt_in + (size_t)j * 256 * DM; d.ldb = 64; d.kb = 16384; return d; },
    [=](int j, const f32x16 (&acc)[2][4], int wm, int wn, int ln) {
      if (j < 4) epi_store_u(acc, wm, wn, ln, z, NIN, j * 128);
      else if (j < 6) epi_store_bf16(acc, wm, wn, ln, z, NIN, 512 + (j - 4) * 256, 1.f);
      else if (j != 10 && j != 11) epi_store_bf16(acc, wm, wn, ln, z, NIN, j * 256, 1.f);
      if (j == 8 || j == 9) epi_store_bf16_T(acc, wm, wn, ln, kT, 128, (j - 8) * 256);
      if (j == 10 || j == 11) epi_store_bf16_T(acc, wm, wn, ln, vT, 128, (j - 10) * 256);
    });

  {
    const int w4 = wave & 3, kh = wave >> 2;
    f32x16 acc = zero16();
    const u16* arow = hbuf + (size_t)(w4 * 32 + (lane & 31)) * DM + kh * 512 + (lane >> 5) * 8;
    const u16* brow = wt_in + (size_t)(NIN + (lane & 31)) * DM + kh * 512 + (lane >> 5) * 8;
#pragma unroll 8
    for (int ks = 0; ks < 32; ++ks) acc = __builtin_amdgcn_mfma_f32_32x32x16_bf16(ld_frag_g(arow + ks * 16), ld_frag_g(brow + ks * 16), acc, 0, 0, 0);
    const int col = lane & 31;
    float* gx = (float*)lds + (w4 * 64 + (lane >> 5) * 8 + col) * 16;
    if (kh == 1 && col < 8) {
#pragma unroll
      for (int r = 0; r < 16; r += 4) *(float4*)(gx + r) = make_float4(acc[r], acc[r + 1], acc[r + 2], acc[r + 3]);
    }
    __syncthreads();
    if (kh == 0 && col < 8) {
      const float bias = p.b_if[l * 8 + col];
#pragma unroll
      for (int r = 0; r < 16; ++r) gates[(size_t)(w4 * 32 + rowmap(r, lane)) * 8 + col] = acc[r] + gx[r] + bias;
    }
  }
  {
    float* halo = (float*)(ws + WS_HALO) + ((size_t)(l * 256 + tile) * 2) * 512;
    __syncthreads();
    const int c = tid;
#pragma unroll
    for (int tt = 0; tt < 2; ++tt) {
      const size_t r = (size_t)(126 + tt) * NIN;
      halo[tt * 512 + c] = bf2f(z[r + c]);
    }
  }
  __syncthreads();
  float* kw = (float*)(lds + 2 * 34816);
  if (wave < 4) {
    const int h = wave;
    const int s0 = 2 * lane, s1 = s0 + 1;
    const float f0 = gates[s0 * 8 + 4 + h], f1 = gates[s1 * 8 + 4 + h];
    const float i0 = gates[s0 * 8 + h], i1 = gates[s1 * 8 + h];
    const float ls0 = fminf(f0, 0.f) - log1pf(__expf(-fabsf(f0))), ls1 = fminf(f1, 0.f) - log1pf(__expf(-fabsf(f1)));
    const float pr = ls0 + ls1;
    float inc = pr;
#pragma unroll
    for (int o = 1; o < 64; o <<= 1) { const float t = shfl_idx(inc, lane >= o ? lane - o : lane); if (lane >= o) inc += t; }
    const float b0 = (inc - pr) + ls0, b1 = b0 + ls1;
    const float bL = __builtin_bit_cast(float, __builtin_amdgcn_readlane(__builtin_bit_cast(int, inc), 63));
    const float g0 = bL - b0 + i0, g1 = bL - b1 + i1;
    const float ml = wave_max(fmaxf(g0, g1));
    const float sc = 0.08838834764831845f;
    kw[h * 128 + s0] = __expf(g0 - ml) * sc; kw[h * 128 + s1] = __expf(g1 - ml) * sc;
    float* bcum = (float*)(ws + WS_BCUM) + ((size_t)tile * 4 + h) * 128;
    bcum[s0] = b0; bcum[s1] = b1;
    if (lane == 0) { ((float*)(ws + WS_MLOC))[tile * 4 + h] = ml; ((float*)(ws + WS_BL))[tile * 4 + h] = bL; }
  }
  __syncthreads();
  float* kvloc = (float*)(ws + WS_KVLOC) + (size_t)tile * 4 * 16384;
  float* nloc = (float*)(ws + WS_NLOC) + (size_t)tile * 4 * 128;
  for (int h = 0; h < 4; ++h) {
    unsigned char* VTl = lds; unsigned char* KWl = lds + 34816;
    uint4 kreg[4];
#pragma unroll
    for (int i = 0; i < 4; ++i) { const int c = tid + i * NT, row = c >> 4, cc = c & 15; kreg[i] = *(const uint4*)(kT + h * 16384 + (size_t)row * 128 + cc * 8); }
    stage_rows256(VTl, vT + h * 16384, 128);
#pragma unroll
    for (int i = 0; i < 4; ++i) {
      const int c = tid + i * NT, row = c >> 4, cc = c & 15;
      const uint4 v = kreg[i];
      const float* kwp = kw + h * 128 + cc * 8;
      const float e0 = bflo(v.x) * kwp[0], e1 = bfhi(v.x) * kwp[1], e2 = bflo(v.y) * kwp[2], e3 = bfhi(v.y) * kwp[3];
      const float e4 = bflo(v.z) * kwp[4], e5 = bfhi(v.z) * kwp[5], e6 = bflo(v.w) * kwp[6], e7 = bfhi(v.w) * kwp[7];
      uint4 o; o.x = pk2(e0, e1); o.y = pk2(e2, e3); o.z = pk2(e4, e5); o.w = pk2(e6, e7);
      *(uint4*)(KWl + row * P272 + cc * 16) = o;
      float sm = ((e0 + e1) + (e2 + e3)) + ((e4 + e5) + (e6 + e7));
      sm += shx<1>(sm); sm += shx<2>(sm); sm += shx<4>(sm); sm += shx<8>(sm);
      if (cc == 0) nloc[h * 128 + row] = sm;
    }
    __syncthreads();
    {
      const int tr = wave >> 1, tc0 = (wave & 1) * 2;
      f32x16 a0 = zero16(), a1 = zero16();
      const unsigned char* ap = VTl + (tr * 32 + (lane & 31)) * P272 + (lane >> 5) * 16;
      const unsigned char* bp = KWl + (tc0 * 32 + (lane & 31)) * P272 + (lane >> 5) * 16;
#pragma unroll
      for (int ks = 0; ks < 8; ++ks) {
        const bf16x8 a = ld_frag(ap + ks * 32);
        a0 = __builtin_amdgcn_mfma_f32_32x32x16_bf16(a, ld_frag(bp + ks * 32), a0, 0, 0, 0);
        a1 = __builtin_amdgcn_mfma_f32_32x32x16_bf16(a, ld_frag(bp + 32 * P272 + ks * 32), a1, 0, 0, 0);
      }
      float* dst = kvloc + h * 16384;
#pragma unroll
      for (int r = 0; r < 16; ++r) {
        const int v = tr * 32 + rowmap(r, lane);
        dst[v * 128 + tc0 * 32 + (lane & 31)] = a0[r];
        dst[v * 128 + (tc0 + 1) * 32 + (lane & 31)] = a1[r];
      }
    }
    __syncthreads();
  }
}

DEV void phaseB(const Params& p, unsigned char* lds) {
  unsigned char* ws = opaque_ptr(p.ws);
  const int tid = opaque_tid();
  float* wd = (float*)lds; float* wl = wd + 128; float* mst = wl + 128; float* blv = mst + 128; float* mlv = blv + 128;
  for (int vb = blockIdx.x; vb < 256; vb += gridDim.x) {
    const int bh = vb >> 5, b = bh >> 2, h = bh & 3;
    const int e = (vb & 31) * 512 + tid;
    __syncthreads();
    if (tid < 128) { const int tile = b * 128 + tid; blv[tid] = ((const float*)(ws + WS_BL))[tile * 4 + h]; mlv[tid] = ((const float*)(ws + WS_MLOC))[tile * 4 + h]; }
    __syncthreads();
    if (tid == 0) {
      float m = 0.f;
      for (int c = 0; c < 128; ++c) {
        const float bl = blv[c], ml = mlv[c];
        const float mn = fmaxf(bl + m, ml);
        wd[c] = __expf(bl + m - mn); wl[c] = __expf(ml - mn); mst[c] = m; m = mn;
      }
    }
    __syncthreads();
    const float* kv = (const float*)(ws + WS_KVLOC) + ((size_t)(b * 128) * 4 + h) * 16384 + e;
    u16* cs = (u16*)(ws + WS_CSTATE) + ((size_t)(b * 128) * 4 + h) * 16384 + e;
    float C = 0.f;
#pragma unroll 1
    for (int c0 = 0; c0 < 128; c0 += 32) {
      float v[32];
#pragma unroll
      for (int q = 0; q < 32; ++q) v[q] = kv[(size_t)(c0 + q) * 4 * 16384];
#pragma unroll
      for (int q = 0; q < 32; ++q) {
        cs[(size_t)(c0 + q) * 4 * 16384] = f2bf(C);
        C = wd[c0 + q] * C + wl[c0 + q] * v[q];
      }
    }
    if ((vb & 31) == 0 && tid < 128) {
      const float* nl = (const float*)(ws + WS_NLOC) + ((size_t)(b * 128) * 4 + h) * 128 + tid;
      float* ns = (float*)(ws + WS_NSTATE) + ((size_t)(b * 128) * 4 + h) * 128 + tid;
      float n = 0.f;
      for (int c = 0; c < 128; ++c) { ns[(size_t)c * 512] = n; n = wd[c] * n + wl[c] * nl[(size_t)c * 512]; }
      ((float*)(ws + WS_MSTATE))[(b * 128 + tid) * 4 + h] = mst[tid];
    }
  }
}

DEV float erf_as(float x) {
  const float ax = fabsf(x);
  const float t = __builtin_amdgcn_rcpf(1.f + 0.3275911f * ax);
  const float poly = ((((1.061405429f * t - 1.453152027f) * t + 1.421413741f) * t - 0.284496736f) * t + 0.254829592f) * t;
  const float y = 1.f - poly * __expf(-ax * ax);
  return copysignf(y, x);
}
DEV unsigned ordkey(float f) { const unsigned u = __float_as_uint(f); return (u & 0x80000000u) ? ~u : (u | 0x80000000u); }
DEV float unordkey(unsigned k) { return (k & 0x80000000u) ? __uint_as_float(k & 0x7fffffffu) : __uint_as_float(~k); }
#define CE_DESC(a, b) { const unsigned hi__ = max(a, b), lo__ = min(a, b); a = hi__; b = lo__; }
DEV void sort16_desc(unsigned (&a)[16]) {
#pragma unroll
  for (int k = 2; k <= 16; k <<= 1) {
#pragma unroll
    for (int j = k >> 1; j > 0; j >>= 1) {
#pragma unroll
      for (int i = 0; i < 16; ++i) {
        const int l = i ^ j;
        if (l > i) {
          if ((i & k) == 0 || k == 16) { CE_DESC(a[i], a[l]); } else { CE_DESC(a[l], a[i]); }
        }
      }
    }
  }
}
DEV void merge16_desc(unsigned (&a)[16]) {
#pragma unroll
  for (int j = 8; j > 0; j >>= 1) {
#pragma unroll
    for (int i = 0; i < 16; ++i) { const int l = i ^ j; if (l > i) { CE_DESC(a[i], a[l]); } }
  }
}
#define INSERT16(list, key_)                                                         \
  {                                                                                  \
    unsigned kx_ = (key_);                                                           \
    _Pragma("unroll") for (int q_ = 0; q_ < 16; ++q_) {                              \
      const unsigned hi_ = max(list[q_], kx_); kx_ = min(list[q_], kx_); list[q_] = hi_; \
    }                                                                                \
  }

DEV void epi_topk1(const f32x16 (&acc)[2][4], int wm, int wn, int lane, int hh, const float* rsv, unsigned* topG) {
  const int tl = lane & 31, h = lane >> 5;
#pragma unroll
  for (int mi = 0; mi < 2; ++mi) {
    const int row = wm * 64 + mi * 32 + tl;
    const float rs = rsv[row];
    unsigned L[16];
#pragma unroll
    for (int ni = 0; ni < 4; ++ni) {
      unsigned B[16];
#pragma unroll
      for (int r = 0; r < 16; ++r) B[r] = (ordkey(acc[mi][ni][r] * rs) & ~127u) | (unsigned)(127 - (ni * 32 + 8 * (r >> 2) + 4 * h + (r & 3)));
      sort16_desc(B);
      if (ni == 0) {
#pragma unroll
        for (int i = 0; i < 16; ++i) L[i] = B[i];
      } else {
#pragma unroll
        for (int i = 0; i < 16; ++i) L[i] = max(L[i], B[15 - i]);
        merge16_desc(L);
      }
    }
    unsigned P[16];
#pragma unroll
    for (int i = 0; i < 16; ++i) P[i] = (unsigned)__builtin_amdgcn_ds_bpermute((lane ^ 32) << 2, (int)L[i]);
#pragma unroll
    for (int i = 0; i < 16; ++i) L[i] = max(L[i], P[15 - i]);
    merge16_desc(L);
    if (h == 0) {
      uint4* tp = (uint4*)(topG + ((size_t)(hh * 2 + wn) * 128 + row) * 16);
      tp[0] = make_uint4(L[0], L[1], L[2], L[3]); tp[1] = make_uint4(L[4], L[5], L[6], L[7]);
      tp[2] = make_uint4(L[8], L[9], L[10], L[11]); tp[3] = make_uint4(L[12], L[13], L[14], L[15]);
    }
  }
}
DEV void topk_stage2(const unsigned* topG, int t, int hh, unsigned char* R4) {
  unsigned L0[16], L1[16];
  {
    const uint4* p0 = (const uint4*)(topG + ((size_t)(hh * 2 + 0) * 128 + t) * 16); const uint4* p1 = (const uint4*)(topG + ((size_t)(hh * 2 + 1) * 128 + t) * 16);
#pragma unroll
    for (int q = 0; q < 4; ++q) {
      const uint4 a = p0[q], b = p1[q];
      L0[4 * q] = a.x; L0[4 * q + 1] = a.y; L0[4 * q + 2] = a.z; L0[4 * q + 3] = a.w;
      L1[4 * q] = b.x; L1[4 * q + 1] = b.y; L1[4 * q + 2] = b.z; L1[4 * q + 3] = b.w;
    }
  }
  float v0[16], v1[16];
#pragma unroll
  for (int i = 0; i < 16; ++i) { v0[i] = unordkey(L0[i] & ~127u); v1[i] = unordkey(L1[i] & ~127u); }
#define PK_KEY(i_, j_) ((ordkey(v0[i_] + v1[j_]) & ~255u) | (unsigned)(255 - ((i_) * 16 + (j_))))
  unsigned L2[16], A1[16], B0[16], B1[16];
#pragma unroll
  for (int j = 0; j < 16; ++j) L2[j] = PK_KEY(0, j);
#pragma unroll
  for (int j = 0; j < 8; ++j) { A1[j] = PK_KEY(1, j); A1[8 + j] = 0u; }
#pragma unroll
  for (int i = 0; i < 16; ++i) L2[i] = max(L2[i], A1[15 - i]);
  merge16_desc(L2);
  B0[0] = PK_KEY(2, 0); B0[1] = PK_KEY(2, 1); B0[2] = PK_KEY(2, 2); B0[3] = PK_KEY(2, 3); B0[4] = PK_KEY(2, 4);
  B0[5] = PK_KEY(3, 0); B0[6] = PK_KEY(3, 1); B0[7] = PK_KEY(3, 2); B0[8] = PK_KEY(3, 3);
  B0[9] = PK_KEY(4, 0); B0[10] = PK_KEY(4, 1); B0[11] = PK_KEY(4, 2);
  B0[12] = PK_KEY(5, 0); B0[13] = PK_KEY(5, 1); B0[14] = PK_KEY(6, 0); B0[15] = PK_KEY(6, 1);
  B1[0] = PK_KEY(7, 0); B1[1] = PK_KEY(7, 1);
#pragma unroll
  for (int i = 8; i < 16; ++i) B1[i - 6] = PK_KEY(i, 0);
#pragma unroll
  for (int i = 10; i < 16; ++i) B1[i] = 0u;
  sort16_desc(B0); sort16_desc(B1);
#pragma unroll
  for (int i = 0; i < 16; ++i) B0[i] = max(B0[i], B1[15 - i]);
  merge16_desc(B0);
#pragma unroll
  for (int i = 0; i < 16; ++i) L2[i] = max(L2[i], B0[15 - i]);
  merge16_desc(L2);
#undef PK_KEY
  float fv[16]; int eid[16];
  unsigned p0[4], p1[4];
#pragma unroll
  for (int w = 0; w < 4; ++w) {
    p0[w] = (127u - (L0[4 * w] & 127u)) | ((127u - (L0[4 * w + 1] & 127u)) << 8) | ((127u - (L0[4 * w + 2] & 127u)) << 16) | ((127u - (L0[4 * w + 3] & 127u)) << 24);
    p1[w] = (127u - (L1[4 * w] & 127u)) | ((127u - (L1[4 * w + 1] & 127u)) << 8) | ((127u - (L1[4 * w + 2] & 127u)) << 16) | ((127u - (L1[4 * w + 3] & 127u)) << 24);
  }
#pragma unroll
  for (int k = 0; k < 16; ++k) {
    fv[k] = unordkey(L2[k] & ~255u);
    const unsigned c = 255u - (L2[k] & 255u), ci = c >> 4, cj = c & 15u;
    const unsigned a_lo = (ci & 8u) ? p0[2] : p0[0], a_hi = (ci & 8u) ? p0[3] : p0[1];
    const unsigned b_lo = (cj & 8u) ? p1[2] : p1[0], b_hi = (cj & 8u) ? p1[3] : p1[1];
    const unsigned i0 = __builtin_amdgcn_perm(a_hi, a_lo, 0x0c0c0c00u | (ci & 7u));
    const unsigned i1 = __builtin_amdgcn_perm(b_hi, b_lo, 0x0c0c0c00u | (cj & 7u));
    eid[k] = (int)(i0 * 128u + i1);
  }
  float sum = 0.f;
  const float fmx = fv[0];
#pragma unroll
  for (int k = 0; k < 16; ++k) { fv[k] = __expf(fv[k] - fmx); sum += fv[k]; }
  const float inv = 1.f / sum;
  int* eo = (int*)(R4 + (size_t)t * 1024) + hh * 16;
  float* go = (float*)(R4 + (size_t)t * 1024 + 512) + hh * 16;
#pragma unroll
  for (int k = 0; k < 16; k += 4) {
    *(int4*)(eo + k) = make_int4(eid[k], eid[k + 1], eid[k + 2], eid[k + 3]);
    *(float4*)(go + k) = make_float4(fv[k] * inv, fv[k + 1] * inv, fv[k + 2] * inv, fv[k + 3] * inv);
  }
}

DEV void phaseC_tile(const Params& p, unsigned char* lds, int l_in, int tile_in, bool last) {
  int l = __builtin_amdgcn_readfirstlane(l_in), tile = __builtin_amdgcn_readfirstlane(tile_in);
  asm volatile("" : "+s"(l), "+s"(tile));
  unsigned char* ws = opaque_ptr(p.ws);
  const int tid = opaque_tid(), lane = tid & 63, wave = tid >> 6;
  const int bidx = tile >> 7;
  u16* z = (u16*)(ws + WS_Z) + (size_t)tile * 128 * NIN;
  unsigned char* zslot = ws + WS_Z + (size_t)tile * ZSLOT;
  u16* R1 = (u16*)(ws + WS_KVLOC + (size_t)tile * 256 * 1024);
  u16* R2 = (u16*)(zslot + R2_OFF);
  unsigned char* R3 = zslot + R3_OFF;
  unsigned char* R4 = zslot + R4_OFF;
  u16* xs = (u16*)(p.out + (size_t)tile * 128 * DM + 65536);
  const void* xsrc = (l == 0) ? (const void*)(p.x + (size_t)tile * 128 * DM) : (const void*)xs;
  const float* gates = (const float*)(ws + WS_GATES) + (size_t)tile * 128 * 8;

  {
    unsigned char* KPl = lds; unsigned char* VTl = lds + 34816; unsigned char* CTl = lds + 69632;
    float* sm = (float*)(lds + 104448);
    float* avs = sm; float* Mt = sm + 128; float* iwv = sm + 256; float* emt = sm + 384; float* nrm = sm + 512; float* nst = sm + 640;
    float* HL = (float*)VTl;
    const int rb = wave >> 1, half = wave & 1;
    for (int h = 0; h < 4; ++h) {
      stage_rows256x3(KPl, z + 2048 + h * 128, NIN, VTl, (const u16*)(ws + WS_VT) + ((size_t)tile * 4 + h) * 16384, 128, CTl, (const u16*)(ws + WS_CSTATE) + ((size_t)tile * 4 + h) * 16384, 128);
      const float mprev = ((const float*)(ws + WS_MSTATE))[tile * 4 + h];
      if (wave == 0) {
        const int s0 = 2 * lane, s1 = s0 + 1;
        const float* bc = (const float*)(ws + WS_BCUM) + ((size_t)tile * 4 + h) * 128;
        const float b0 = bc[s0], b1 = bc[s1];
        const float a0 = gates[s0 * 8 + h] - b0, a1 = gates[s1 * 8 + h] - b1;
        float v = fmaxf(a0, a1);
#pragma unroll
        for (int o = 1; o < 64; o <<= 1) { const float t = shfl_idx(v, lane >= o ? lane - o : lane); if (lane >= o) v = fmaxf(v, t); }
        float ex = shfl_idx(v, lane >= 1 ? lane - 1 : lane); if (lane == 0) ex = -INFINITY;
        const float A0 = fmaxf(ex, a0), A1 = fmaxf(A0, a1);
        const float M0 = fmaxf(mprev, A0), M1 = fmaxf(mprev, A1);
        avs[s0] = a0; avs[s1] = a1; Mt[s0] = M0; Mt[s1] = M1;
        iwv[s0] = __expf(mprev - M0); iwv[s1] = __expf(mprev - M1);
        emt[s0] = __expf(-b0 - M0); emt[s1] = __expf(-b1 - M1);
      } else if (wave == 1) {
        const float* ns = (const float*)(ws + WS_NSTATE) + ((size_t)tile * 4 + h) * 128;
        nst[lane] = ns[lane]; nst[lane + 64] = ns[lane + 64];
      }
      bf16x8 qf[8];
      {
        const u16* qrow = z + (size_t)(rb * 32 + (lane & 31)) * NIN + 1536 + h * 128 + (lane >> 5) * 8;
#pragma unroll
        for (int ks = 0; ks < 8; ++ks) qf[ks] = ld_frag_g(qrow + ks * 16);
      }
      __syncthreads();
      f32x16 s0a = zero16(), s1a = zero16();
      {
        const unsigned char* bp = KPl + (half * 64 + (lane & 31)) * P272 + (lane >> 5) * 16;
#pragma unroll
        for (int ks = 0; ks < 8; ++ks) {
          s0a = __builtin_amdgcn_mfma_f32_32x32x16_bf16(qf[ks], ld_frag(bp + ks * 32), s0a, 0, 0, 0);
          s1a = __builtin_amdgcn_mfma_f32_32x32x16_bf16(qf[ks], ld_frag(bp + 32 * P272 + ks * 32), s1a, 0, 0, 0);
        }
      }
      {
        const float sc = 0.08838834764831845f;
        const int sA = half * 64 + (lane & 31), sB = sA + 32;
        const float avA = avs[sA], avB = avs[sB];
#pragma unroll
        for (int g = 0; g < 4; ++g) {
          const int t0 = rb * 32 + 8 * g + 4 * (lane >> 5);
          const float4 m4 = *(const float4*)(Mt + t0);
          const float mm[4] = {m4.x, m4.y, m4.z, m4.w};
#pragma unroll
          for (int e = 0; e < 4; ++e) {
            const int t = t0 + e;
            s0a[4 * g + e] = (sA <= t) ? s0a[4 * g + e] * sc * __expf(avA - mm[e]) : 0.f;
            s1a[4 * g + e] = (sB <= t) ? s1a[4 * g + e] * sc * __expf(avB - mm[e]) : 0.f;
          }
        }
      }
      __syncthreads();
      {
        u16* P = (u16*)KPl;
        const int sA = half * 64 + (lane & 31), sB = sA + 32;
#pragma unroll
        for (int r = 0; r < 16; ++r) {
          const int t = rb * 32 + rowmap(r, lane);
          P[t * (P272 / 2) + sA] = f2bf(s0a[r]);
          P[t * (P272 / 2) + sB] = f2bf(s1a[r]);
        }
      }
      __syncthreads();
      {
        const int t = tid >> 2, qd = tid & 3;
        const unsigned char* pr = KPl + t * P272 + qd * 64;
        float rs = 0.f;
#pragma unroll
        for (int i = 0; i < 4; ++i) { const uint4 v = *(const uint4*)(pr + i * 16); rs += (bflo(v.x) + bfhi(v.x)) + (bflo(v.y) + bfhi(v.y)) + (bflo(v.z) + bfhi(v.z)) + (bflo(v.w) + bfhi(v.w)); }
        const u16* qr = z + (size_t)t * NIN + 1536 + h * 128 + qd * 32;
        const float* nn = nst + qd * 32;
        float qn = 0.f;
#pragma unroll
        for (int i = 0; i < 4; ++i) {
          const uint4 v = *(const uint4*)(qr + i * 8);
          qn += bflo(v.x) * nn[i * 8 + 0] + bfhi(v.x) * nn[i * 8 + 1] + bflo(v.y) * nn[i * 8 + 2] + bfhi(v.y) * nn[i * 8 + 3] +
                bflo(v.z) * nn[i * 8 + 4] + bfhi(v.z) * nn[i * 8 + 5] + bflo(v.w) * nn[i * 8 + 6] + bfhi(v.w) * nn[i * 8 + 7];
        }
        rs += shx<1>(rs); rs += shx<2>(rs);
        qn += shx<1>(qn); qn += shx<2>(qn);
        const float den = rs + iwv[t] * qn;
        if (qd == 0) nrm[t] = 1.f / fmaxf(fabsf(den), emt[t]);
      }
      f32x16 n0 = zero16(), n1 = zero16(), c0 = zero16(), c1 = zero16();
      {
        const unsigned char* ap = KPl + (rb * 32 + (lane & 31)) * P272 + (lane >> 5) * 16;
        const unsigned char* vp = VTl + (half * 64 + (lane & 31)) * P272 + (lane >> 5) * 16;
        const unsigned char* cp = CTl + (half * 64 + (lane & 31)) * P272 + (lane >> 5) * 16;
#pragma unroll
        for (int ks = 0; ks < 8; ++ks) {
          const bf16x8 a = ld_frag(ap + ks * 32);
          n0 = __builtin_amdgcn_mfma_f32_32x32x16_bf16(a, ld_frag(vp + ks * 32), n0, 0, 0, 0);
          n1 = __builtin_amdgcn_mfma_f32_32x32x16_bf16(a, ld_frag(vp + 32 * P272 + ks * 32), n1, 0, 0, 0);
          c0 = __builtin_amdgcn_mfma_f32_32x32x16_bf16(qf[ks], ld_frag(cp + ks * 32), c0, 0, 0, 0);
          c1 = __builtin_amdgcn_mfma_f32_32x32x16_bf16(qf[ks], ld_frag(cp + 32 * P272 + ks * 32), c1, 0, 0, 0);
        }
      }
      __syncthreads();
      {
        const int vA = half * 64 + (lane & 31), vB = vA + 32;
#pragma unroll
        for (int g = 0; g < 4; ++g) {
          const int t0 = rb * 32 + 8 * g + 4 * (lane >> 5);
          const float4 iw4 = *(const float4*)(iwv + t0), nr4 = *(const float4*)(nrm + t0);
          const float iw[4] = {iw4.x, iw4.y, iw4.z, iw4.w}, nr[4] = {nr4.x, nr4.y, nr4.z, nr4.w};
#pragma unroll
          for (int e = 0; e < 4; ++e) {
            const int t = t0 + e;
            const float hA = (n0[4 * g + e] + iw[e] * c0[4 * g + e]) * nr[e];
            const float hB = (n1[4 * g + e] + iw[e] * c1[4 * g + e]) * nr[e];
            const float oA = bf2f(z[(size_t)t * NIN + 3072 + h * 128 + vA]), oB = bf2f(z[(size_t)t * NIN + 3072 + h * 128 + vB]);
            HL[t * 132 + vA] = hA / (1.f + __expf(-oA));
            HL[t * 132 + vB] = hB / (1.f + __expf(-oB));
          }
        }
      }
      __syncthreads();
      {
        const int t = tid >> 2, qd = tid & 3;
        const float* hr = HL + t * 132 + qd * 32;
        float v[32]; float ss = 0.f;
#pragma unroll
        for (int i = 0; i < 8; ++i) { const float4 f = *(const float4*)(hr + i * 4); v[4 * i] = f.x; v[4 * i + 1] = f.y; v[4 * i + 2] = f.z; v[4 * i + 3] = f.w; ss += f.x * f.x + f.y * f.y + f.z * f.z + f.w * f.w; }
        ss += shx<1>(ss); ss += shx<2>(ss);
        const float r = rsqrtf(ss * (1.f / 128.f) + EPS);
        const float* gh = p.g_head + l * 512 + h * 128 + qd * 32;
        u16* yo = R1 + (size_t)t * DM + 512 + h * 128 + qd * 32;
#pragma unroll
        for (int i = 0; i < 4; ++i) {
          uint4 o;
          o.x = pk2(v[8 * i + 0] * r * gh[8 * i + 0], v[8 * i + 1] * r * gh[8 * i + 1]);
          o.y = pk2(v[8 * i + 2] * r * gh[8 * i + 2], v[8 * i + 3] * r * gh[8 * i + 3]);
          o.z = pk2(v[8 * i + 4] * r * gh[8 * i + 4], v[8 * i + 5] * r * gh[8 * i + 5]);
          o.w = pk2(v[8 * i + 6] * r * gh[8 * i + 6], v[8 * i + 7] * r * gh[8 * i + 7]);
          *(uint4*)(yo + i * 8) = o;
        }
      }
      __syncthreads();
    }
  }
  {
    const int c = (tid & 255) * 2, th = tid >> 8, t0 = th * 64;
    const float2 w0 = *(const float2*)(p.conv_w + (l * 3 + 0) * 512 + c), w1 = *(const float2*)(p.conv_w + (l * 3 + 1) * 512 + c), w2 = *(const float2*)(p.conv_w + (l * 3 + 2) * 512 + c);
    const float2 cb = *(const float2*)(p.conv_b + l * 512 + c);
    float2 um2 = make_float2(0.f, 0.f), um1 = make_float2(0.f, 0.f);
    if (th == 1) {
      const unsigned xa = *(const unsigned*)(z + (size_t)62 * NIN + c), xb = *(const unsigned*)(z + (size_t)63 * NIN + c);
      um2 = make_float2(bflo(xa), bfhi(xa)); um1 = make_float2(bflo(xb), bfhi(xb));
    } else if ((tile & 127) != 0) {
      const float* halo = (const float*)(ws + WS_HALO) + ((size_t)(l * 256 + tile - 1) * 2) * 512;
      um2 = *(const float2*)(halo + c); um1 = *(const float2*)(halo + 512 + c);
    }
#pragma unroll 1
    for (int tb = t0; tb < t0 + 64; tb += 8) {
      unsigned xw[8], bw[8];
#pragma unroll
      for (int q = 0; q < 8; ++q) { const size_t r = (size_t)(tb + q) * NIN; xw[q] = *(const unsigned*)(z + r + c); bw[q] = *(const unsigned*)(z + r + 512 + c); }
#pragma unroll
      for (int q = 0; q < 8; ++q) {
        const float2 u = make_float2(bflo(xw[q]), bfhi(xw[q]));
        const float y0 = bflo(bw[q]) * (w0.x * um2.x + w1.x * um1.x + w2.x * u.x + cb.x);
        const float y1 = bfhi(bw[q]) * (w0.y * um2.y + w1.y * um1.y + w2.y * u.y + cb.y);
        *(unsigned*)(R1 + (size_t)(tb + q) * DM + c) = pk2(y0, y1);
        um2 = um1; um1 = u;
      }
    }
  }
  __syncthreads();
  float* rowss = (float*)(lds + 110592 + 1024); float* rsv = (float*)(lds + 110592);
  {
    const u16* wt = (const u16*)(ws + WS_WT_OUT + l * 2 * MiB);
    const float* gx = p.g_xattn + l * DM;
    u16* xg = (u16*)R3;
    gemm_run<16>(lds, 4,
      [=](int j) { TileDesc d; d.A = R1; d.lda = DM; d.B = wt + (size_t)j * 256 * DM; d.ldb = 64; d.kb = 16384; return d; },
      [=](int j, const f32x16 (&acc)[2][4], int wm, int wn, int ln) { epi_residual_norm(acc, wm, wn, ln, xsrc, l == 0, xs, j * 256, gx, (u16*)nullptr, rowss); });
    if (tid < 128) { float s_ = 0.f;
#pragma unroll
      for (int q = 0; q < 8; ++q) s_ += rowss[q * 128 + tid];
      rsv[tid] = rsqrtf(s_ * (1.f / DM) + EPS); }
  }
  {
    const u16* wt = (const u16*)(ws + WS_WT_MQ) + (size_t)(l * 2 + bidx) * 1024 * 1024;
    const u16* xg = xs;
    float* pm = (float*)(lds + 110592 + 1024); float* ps = pm + 256;
    gemm_run<16, 3>(lds, 4,
      [=](int j) { TileDesc d; d.A = xg; d.lda = DM; d.B = wt + (size_t)j * 256 * DM; d.ldb = 64; d.kb = 16384; return d; },
      [=](int j, const f32x16 (&acc)[2][4], int wm, int wn, int ln) { epi_softmax_bf16(acc, wm, wn, ln, R2, DM, j * 256, rsv, pm, ps); });
  }
  {
    const u16* wt = (const u16*)(ws + WS_WT_MO) + (size_t)(l * 2 + bidx) * 1024 * 1024;
    const u16* ao = (const u16*)R2;
    const float* gf = p.g_ffn + l * DM;
    gemm_run<16>(lds, 4,
      [=](int j) { TileDesc d; d.A = ao; d.lda = DM; d.B = wt + (size_t)j * 256 * DM; d.ldb = 64; d.kb = 16384; return d; },
      [=](int j, const f32x16 (&acc)[2][4], int wm, int wn, int ln) { epi_residual_norm(acc, wm, wn, ln, xs, false, xs, j * 256, gf, R1, rowss); });
    if (tid < 128) { float s_ = 0.f;
#pragma unroll
      for (int q = 0; q < 8; ++q) s_ += rowss[q * 128 + tid];
      rsv[tid] = rsqrtf(s_ * (1.f / DM) + EPS); }
  }
  {
    const u16* wt = (const u16*)(ws + WS_WT_PQ + l * 4 * MiB);
    unsigned* topG = (unsigned*)R3;
    gemm_run<16, 0, true>(lds, 8,
      [=](int j) { TileDesc d; d.A = R1; d.lda = DM; d.B = wt + (size_t)j * 256 * DM; d.ldb = 64; d.kb = 16384; return d; },
      [=](int j, const f32x16 (&acc)[2][4], int wm, int wn, int ln) { epi_topk1(acc, wm, wn, ln, j, rsv, topG); });
#pragma unroll 1
    for (int it = 0; it < 2; ++it) topk_stage2(topG, tid & 127, (tid >> 7) + 4 * it, R4);
    __syncthreads();
  }
}

DEV void grid_barrier(cg::grid_group& grid) {
  asm volatile("s_waitcnt vmcnt(0)" ::: "memory");
  __syncthreads();
  grid.sync();
  __builtin_amdgcn_fence(__ATOMIC_ACQUIRE, "agent");
  asm volatile("s_waitcnt vmcnt(0)" ::: "memory");
  __syncthreads();
}
DEV void grid_barrier_ctr(unsigned* ctr, unsigned target) {
  asm volatile("s_waitcnt vmcnt(0)" ::: "memory");
  __syncthreads();
  if (threadIdx.x == 0) {
    __builtin_amdgcn_fence(__ATOMIC_RELEASE, "agent");
    asm volatile("s_waitcnt vmcnt(0)" ::: "memory");
    __hip_atomic_fetch_add(ctr, 1u, __ATOMIC_RELAXED, __HIP_MEMORY_SCOPE_AGENT);
    while (__hip_atomic_load(ctr, __ATOMIC_RELAXED, __HIP_MEMORY_SCOPE_AGENT) < target) __builtin_amdgcn_s_sleep(2);
  }
  __syncthreads();
  __builtin_amdgcn_fence(__ATOMIC_ACQUIRE, "agent");
  asm volatile("s_waitcnt vmcnt(0)" ::: "memory");
  __syncthreads();
}

DEV void peer_gather(const Params& p, unsigned char* lds, int l_in, int tile_in, bool last, bool active, unsigned* bar, unsigned& nbar) {
  int l = __builtin_amdgcn_readfirstlane(l_in), tile = __builtin_amdgcn_readfirstlane(tile_in);
  asm volatile("" : "+s"(l), "+s"(tile));
  unsigned char* ws = opaque_ptr(p.ws);
  const int tid = opaque_tid(), lane = tid & 63, wave = __builtin_amdgcn_readfirstlane(tid >> 6);
  const int q = lane & 15, g4 = lane >> 4, q12 = q * 12;
  u16* R1 = (u16*)(ws + WS_KVLOC + (size_t)tile * 256 * 1024);
  unsigned char* R4 = ws + WS_Z + (size_t)tile * ZSLOT + R4_OFF;
  float* xout = p.out + (size_t)tile * 128 * DM;
  u16* xs = (u16*)(xout + 65536);
  int* eidL = (int*)lds;
  float* hacc = (float*)(lds + 65536);
  float* rsvG = (float*)(lds + 131072);
  float* ssq = rsvG + 128;
  const unsigned char* utab = ws + WS_EXP6 + (size_t)(l * 2 + 0) * NEXP * 768;
  const unsigned char* vtab = ws + WS_EXP6 + (size_t)(l * 2 + 1) * NEXP * 768;

  if (active) {
    const float* rsv = (const float*)(lds + 110592);
    float rv = 0.f;
    if (tid < 128) rv = rsv[tid];
    __syncthreads();
    if (tid < 128) rsvG[tid] = rv;
    {
      int ev[32];
#pragma unroll
      for (int i = 0; i < 16; ++i) {
        const int* eo = (const int*)(R4 + (size_t)(wave + 8 * i) * 1024);
        ev[2 * i] = eo[lane]; ev[2 * i + 1] = eo[lane + 64];
      }
#pragma unroll
      for (int i = 0; i < 16; ++i) {
        const int t = wave + 8 * i;
#pragma unroll
        for (int r = 0; r < 2; ++r) {
          const int sel = lane + 64 * r;
          eidL[t * 128 + (sel & 3) * 32 + 2 * (sel >> 3) + ((sel >> 2) & 1)] = ev[2 * i + r];
        }
      }
    }
    __syncthreads();
  }

#define SEG_LD(rsrc_, e_) __builtin_amdgcn_raw_buffer_load_b96(rsrc_, (int)(__umul24((unsigned)(e_), 192u) + (unsigned)q12), 0, 0)
#define LD_GROUP(S_, rsrc_, t_, G_) { const int4* ep_ = (const int4*)(eidL + (t_) * 128 + g4 * 32 + 16 * (G_)); \
    const int4 e0_ = ep_[0], e1_ = ep_[1], e2_ = ep_[2], e3_ = ep_[3]; \
    S_[0] = SEG_LD(rsrc_, e0_.x); S_[1] = SEG_LD(rsrc_, e0_.y); S_[2] = SEG_LD(rsrc_, e0_.z); S_[3] = SEG_LD(rsrc_, e0_.w); \
    S_[4] = SEG_LD(rsrc_, e1_.x); S_[5] = SEG_LD(rsrc_, e1_.y); S_[6] = SEG_LD(rsrc_, e1_.z); S_[7] = SEG_LD(rsrc_, e1_.w); \
    S_[8] = SEG_LD(rsrc_, e2_.x); S_[9] = SEG_LD(rsrc_, e2_.y); S_[10] = SEG_LD(rsrc_, e2_.z); S_[11] = SEG_LD(rsrc_, e2_.w); \
    S_[12] = SEG_LD(rsrc_, e3_.x); S_[13] = SEG_LD(rsrc_, e3_.y); S_[14] = SEG_LD(rsrc_, e3_.z); S_[15] = SEG_LD(rsrc_, e3_.w); }

#pragma unroll 1
  for (int c = 0; c < 4; ++c) {
    if (active) {
      const __amdgpu_buffer_rsrc_t rsrc = mkrsrc(utab + (size_t)c * NEXP * 192);
      u32x3 s0[16], s1[16];
      u32x2 hx[4];
      {
        const GAS u32x2* xrow = (const GAS u32x2*)(R1 + (size_t)wave * DM) + 64 * c + q;
#pragma unroll
        for (int j = 0; j < 4; ++j) hx[j] = xrow[16 * j];
        LD_GROUP(s0, rsrc, wave, 0);
      }
#pragma unroll 1
      for (int i = 0; i < 16; ++i) {
        const int t = wave + 8 * i, tn = wave + 8 * (i < 15 ? i + 1 : 15);
        float P[32];
        LD_GROUP(s1, rsrc, t, 1);
        u32x2 hxn[4];
        {
          const GAS u32x2* xrow = (const GAS u32x2*)(R1 + (size_t)tn * DM) + 64 * c + q;
#pragma unroll
          for (int j = 0; j < 4; ++j) hxn[j] = xrow[16 * j];
        }
        const unsigned hvb[8] = {hx[0].x, hx[0].y, hx[1].x, hx[1].y, hx[2].x, hx[2].y, hx[3].x, hx[3].y};
#define U_PAIR(S_, pp_, base_) { \
          u32x6 w_ = (u32x6){S_[2 * (pp_)].x, S_[2 * (pp_)].y, S_[2 * (pp_)].z, S_[2 * (pp_) + 1].x, S_[2 * (pp_) + 1].y, S_[2 * (pp_) + 1].z}; \
          asm volatile("" : "+v"(w_));        \
          const bf16x32 uf = __builtin_amdgcn_cvt_scalef32_pk32_bf16_fp6(w_, 1.0f); \
          float sa = 0.f, sb = 0.f; \
          U_DOT(0) U_DOT(1) U_DOT(2) U_DOT(3) U_DOT(4) U_DOT(5) U_DOT(6) U_DOT(7) \
          P[(base_) + 2 * (pp_)] = sa; P[(base_) + 2 * (pp_) + 1] = sb; \
          __builtin_amdgcn_sched_barrier(0); }
#define U_DOT(I) sa = __builtin_amdgcn_fdot2_f32_bf16(__builtin_shufflevector(uf, uf, 2 * (I), 2 * (I) + 1), __builtin_bit_cast(bf16x2, hvb[I]), sa, false); \
                 sb = __builtin_amdgcn_fdot2_f32_bf16(__builtin_shufflevector(uf, uf, 16 + 2 * (I), 17 + 2 * (I)), __builtin_bit_cast(bf16x2, hvb[I]), sb, false);
        U_PAIR(s0, 0, 0) U_PAIR(s0, 1, 0) U_PAIR(s0, 2, 0) U_PAIR(s0, 3, 0) U_PAIR(s0, 4, 0) U_PAIR(s0, 5, 0) U_PAIR(s0, 6, 0) U_PAIR(s0, 7, 0)
        __builtin_amdgcn_sched_barrier(0);
        LD_GROUP(s0, rsrc, tn, 0);
        __builtin_amdgcn_sched_barrier(0);
        U_PAIR(s1, 0, 16) U_PAIR(s1, 1, 16) U_PAIR(s1, 2, 16) U_PAIR(s1, 3, 16) U_PAIR(s1, 4, 16) U_PAIR(s1, 5, 16) U_PAIR(s1, 6, 16) U_PAIR(s1, 7, 16)
#undef U_DOT
#undef U_PAIR
        {
          const bool b3 = (lane & 8) != 0, b2 = (lane & 4) != 0, b1 = (lane & 2) != 0, b0 = (lane & 1) != 0;
          float A8[16], A4[8], A2[4], A1[2];
#pragma unroll
          for (int n = 0; n < 16; ++n) { const float snd = b3 ? P[n] : P[n + 16], kp = b3 ? P[n + 16] : P[n]; A8[n] = kp + shx<8>(snd); }
#pragma unroll
          for (int n = 0; n < 8; ++n) { const float snd = b2 ? A8[n] : A8[n + 8], kp = b2 ? A8[n + 8] : A8[n]; A4[n] = kp + shx<4>(snd); }
#pragma unroll
          for (int n = 0; n < 4; ++n) { const float snd = b1 ? A4[n] : A4[n + 4], kp = b1 ? A4[n + 4] : A4[n]; A2[n] = kp + shx<2>(snd); }
#pragma unroll
          for (int n = 0; n < 2; ++n) { const float snd = b0 ? A2[n] : A2[n + 2], kp = b0 ? A2[n + 2] : A2[n]; A1[n] = kp + shx<1>(snd); }
          float2* hp = (float2*)(hacc + t * 128 + g4 * 32 + 2 * q);
          if (c == 0) *hp = make_float2(A1[0], A1[1]);
          else { const float2 o = *hp; *hp = make_float2(o.x + A1[0], o.y + A1[1]); }
        }
#pragma unroll
        for (int j = 0; j < 4; ++j) hx[j] = hxn[j];
      }
    }
  }
  if (active) {
    float gv[32];
#pragma unroll
    for (int i = 0; i < 16; ++i) {
      const float* go = (const float*)(R4 + (size_t)(wave + 8 * i) * 1024 + 512);
#pragma unroll
      for (int r = 0; r < 2; ++r) {
        const int pos = lane + 64 * r, w = pos & 31;
        gv[2 * i + r] = go[8 * (w >> 1) + 4 * (w & 1) + (pos >> 5)];
      }
    }
#pragma unroll
    for (int i = 0; i < 16; ++i) {
      const int t = wave + 8 * i;
      const float rs = rsvG[t];
#pragma unroll
      for (int r = 0; r < 2; ++r) {
        const int pos = lane + 64 * r;
        const float am = hacc[t * 128 + pos] * rs * (1.f / 48.f);
        hacc[t * 128 + pos] = gv[2 * i + r] * 0.5f * am * (1.f + erf_as(am * 0.7071067811865476f)) * (1.f / 6.f);
      }
    }
  }
#pragma unroll 1
  for (int c = 0; c < 4; ++c) {
    if (active) {
      const __amdgpu_buffer_rsrc_t rsrc = mkrsrc(vtab + (size_t)c * NEXP * 192);
      u32x3 s0[16], s1[16];
      LD_GROUP(s0, rsrc, wave, 0);
#pragma unroll 1
      for (int i = 0; i < 16; ++i) {
        const int t = wave + 8 * i, tn = wave + 8 * (i < 15 ? i + 1 : 15);
        LD_GROUP(s1, rsrc, t, 1);
        GAS u32x2* xp = (GAS u32x2*)(xs + (size_t)t * DM) + 64 * c + lane;
        const u32x2 xw = *xp;
        f32x4 xo = {bflo(xw.x), bfhi(xw.x), bflo(xw.y), bfhi(xw.y)};
        f32x16 ov;
#pragma unroll
        for (int k = 0; k < 16; ++k) ov[k] = 0.f;
#define V_PAIR(S_, pp_, cfa_, cfb_) { \
          u32x6 w_ = (u32x6){S_[2 * (pp_)].x, S_[2 * (pp_)].y, S_[2 * (pp_)].z, S_[2 * (pp_) + 1].x, S_[2 * (pp_) + 1].y, S_[2 * (pp_) + 1].z}; \
          asm volatile("" : "+v"(w_)); \
          const f32x32 vf = __builtin_amdgcn_cvt_scalef32_pk32_f32_fp6(w_, 1.0f); \
          ov += __builtin_shufflevector(vf, vf, 0, 1, 2, 3, 4, 5, 6, 7, 8, 9, 10, 11, 12, 13, 14, 15) * (cfa_); \
          ov += __builtin_shufflevector(vf, vf, 16, 17, 18, 19, 20, 21, 22, 23, 24, 25, 26, 27, 28, 29, 30, 31) * (cfb_); \
          __builtin_amdgcn_sched_barrier(0); }
        {
          const float4* cp = (const float4*)(hacc + t * 128 + g4 * 32);
          const float4 c0 = cp[0], c1 = cp[1], c2 = cp[2], c3 = cp[3];
          V_PAIR(s0, 0, c0.x, c0.y) V_PAIR(s0, 1, c0.z, c0.w) V_PAIR(s0, 2, c1.x, c1.y) V_PAIR(s0, 3, c1.z, c1.w)
          V_PAIR(s0, 4, c2.x, c2.y) V_PAIR(s0, 5, c2.z, c2.w) V_PAIR(s0, 6, c3.x, c3.y) V_PAIR(s0, 7, c3.z, c3.w)
        }
        __builtin_amdgcn_sched_barrier(0);
        LD_GROUP(s0, rsrc, tn, 0);
        __builtin_amdgcn_sched_barrier(0);
        {
          const float4* cp = (const float4*)(hacc + t * 128 + g4 * 32 + 16);
          const float4 c0 = cp[0], c1 = cp[1], c2 = cp[2], c3 = cp[3];
          V_PAIR(s1, 0, c0.x, c0.y) V_PAIR(s1, 1, c0.z, c0.w) V_PAIR(s1, 2, c1.x, c1.y) V_PAIR(s1, 3, c1.z, c1.w)
          V_PAIR(s1, 4, c2.x, c2.y) V_PAIR(s1, 5, c2.z, c2.w) V_PAIR(s1, 6, c3.x, c3.y) V_PAIR(s1, 7, c3.z, c3.w)
        }
#undef V_PAIR
        {
          const bool b5 = (lane & 32) != 0, b4 = (lane & 16) != 0;
          float B8[8], B4[4], os[16];
#pragma unroll
          for (int k = 0; k < 16; ++k) { os[k] = ov[k]; asm volatile("" : "+v"(os[k])); }
#pragma unroll
          for (int n = 0; n < 8; ++n) { const float snd = b5 ? os[n] : os[n + 8], kp = b5 ? os[n + 8] : os[n]; B8[n] = kp + shfl_idx(snd, lane ^ 32); }
#pragma unroll
          for (int n = 0; n < 4; ++n) { const float snd = b4 ? B8[n] : B8[n + 4], kp = b4 ? B8[n + 4] : B8[n]; B4[n] = kp + shx<16>(snd); }
          xo.x += B4[0]; xo.y += B4[1]; xo.z += B4[2]; xo.w += B4[3];
        }
        *xp = (u32x2){pk2(xo.x, xo.y), pk2(xo.z, xo.w)};
        const float sq = wave_sum(xo.x * xo.x + xo.y * xo.y + xo.z * xo.z + xo.w * xo.w);
        if (lane == 0) ssq[t] = (c == 0) ? sq : ssq[t] + sq;
      }
    }
  }
#undef LD_GROUP
#undef SEG_LD
  if (active) {
    float4 gg[4];
#pragma unroll
    for (int j = 0; j < 4; ++j) gg[j] = last ? ((const float4*)p.g_final)[lane + 64 * j] : ((const float4*)(p.g_mix + (l + 1) * DM))[lane + 64 * j];
#define FIN_LOAD(buf_, i_) { const uint2* xr_ = (const uint2*)(xs + (size_t)(wave + 8 * (i_)) * DM); _Pragma("unroll") for (int j = 0; j < 4; ++j) buf_[j] = xr_[lane + 64 * j]; }
#define FIN_STORE(buf_, i_) { const int t_ = wave + 8 * (i_); const float r3_ = rsqrtf(ssq[t_] * (1.f / DM) + EPS); \
      if (last) { float4* xw_ = (float4*)(xout + (size_t)t_ * DM); \
        _Pragma("unroll") for (int j = 0; j < 4; ++j) xw_[lane + 64 * j] = make_float4(bflo(buf_[j].x) * r3_ * gg[j].x, bfhi(buf_[j].x) * r3_ * gg[j].y, bflo(buf_[j].y) * r3_ * gg[j].z, bfhi(buf_[j].y) * r3_ * gg[j].w); } \
      else { uint2* ho_ = (uint2*)(R1 + (size_t)t_ * DM) + lane; \
        _Pragma("unroll") for (int j = 0; j < 4; ++j) ho_[64 * j] = make_uint2(pk2(bflo(buf_[j].x) * r3_ * gg[j].x, bfhi(buf_[j].x) * r3_ * gg[j].y), pk2(bflo(buf_[j].y) * r3_ * gg[j].z, bfhi(buf_[j].y) * r3_ * gg[j].w)); } }
    uint2 xa[4], xb[4];
    FIN_LOAD(xa, 0);
    const int nstream = last ? 8 : 16;
#pragma unroll 1
    for (int i = 0; i < nstream; i += 2) {
      FIN_LOAD(xb, i + 1);
      FIN_STORE(xa, i);
      if (i + 2 < nstream) FIN_LOAD(xa, i + 2);
      FIN_STORE(xb, i + 1);
    }
    if (last) {
      uint2 xr[8][4];
#pragma unroll
      for (int i = 0; i < 8; ++i) FIN_LOAD(xr[i], 8 + i);
      asm volatile("s_waitcnt vmcnt(0)" ::: "memory");
      __syncthreads();
#pragma unroll
      for (int i = 0; i < 8; ++i) FIN_STORE(xr[i], 8 + i);
    }
#undef FIN_LOAD
#undef FIN_STORE
  }
  __syncthreads();
}

__global__ void __launch_bounds__(NT) fwd_mega(Params p) {
  cg::grid_group grid = cg::this_grid();
  __shared__ __attribute__((aligned(16))) unsigned char lds[LDS_BYTES];
  unsigned char* ws = p.ws;

  phase0(p, lds);
  grid_barrier(grid);

  for (int job = blockIdx.x; job < 64; job += gridDim.x) memkv_job(p, lds, job);
  unsigned* bar = (unsigned*)(ws + WS_BAR);
  unsigned nbar = 0;
  const int iters = (NTILES + (int)gridDim.x - 1) / (int)gridDim.x;
#pragma unroll 1
  for (int st = 0; st < 3; ++st) {
#pragma unroll 1
    for (int it = 0; it < iters; ++it) {
      const int tile0 = (int)blockIdx.x + it * (int)gridDim.x;
      const bool act = tile0 < NTILES;
      const int tile = act ? tile0 : 0;
      if (st > 0) {
        if (act) phaseC_tile(p, lds, st - 1, tile, st == 2);
        peer_gather(p, lds, st - 1, tile, st == 2, act, bar, nbar);
      }
      if (act) {
        if (st == 0) rmsnorm_tile(p.x + (size_t)tile * 128 * DM, p.g_mix, (u16*)(ws + WS_KVLOC + (size_t)tile * 256 * 1024));
        if (st < 2) phaseA_tile(p, lds, st, tile);
      }
    }
    if (st < 2) {
      grid_barrier_ctr(bar, (unsigned)gridDim.x * (++nbar));
      if (st == 0) for (int job = blockIdx.x; job < 128; job += gridDim.x) { if (job < 64) foldv_job(p, lds, job); else foldq_job(p, lds, job - 64); }
      phaseB(p, lds);
      grid_barrier_ctr(bar, (unsigned)gridDim.x * (++nbar));
    }
  }
}

extern "C" void kernel_launch(void* const* d_in, const int* in_sizes, int n_in, void* d_out, int out_size, void* d_ws, size_t ws_size, hipStream_t stream) {
  static int grid_blocks = 0;
  if (!grid_blocks) {
    int dev = 0, cus = 0, per_cu = 0;
    (void)hipGetDevice(&dev);
    (void)hipDeviceGetAttribute(&cus, hipDeviceAttributeMultiprocessorCount, dev);
    (void)hipOccupancyMaxActiveBlocksPerMultiprocessor(&per_cu, fwd_mega, NT, 0);
    if (per_cu < 1) { fprintf(stderr, "kernel_launch: occupancy query says %d blocks/CU\n", per_cu); per_cu = 1; }
    grid_blocks = cus < NTILES ? cus : NTILES;
    if (ws_size < WS_END || n_in != 21 || out_size != NTOK * DM) { fprintf(stderr, "kernel_launch: bad sizes ws=%zu need=%zu n_in=%d out=%d\n", ws_size, (size_t)WS_END, n_in, out_size); grid_blocks = -1; }
  }
  if (grid_blocks < 0) return;
  Params p{};
  const float** pp = (const float**)&p;
  for (int i = 0; i < 21; ++i) pp[i] = (const float*)d_in[i];
  p.out = (float*)d_out; p.ws = (unsigned char*)d_ws;
  (void)hipMemsetAsync((unsigned char*)d_ws + WS_BAR, 0, 4096, stream);
  void* args[] = {&p};
  hipError_t e = hipLaunchCooperativeKernel((void*)fwd_mega, dim3(grid_blocks), dim3(NT), args, 0, stream);
  if (e != hipSuccess) fprintf(stderr, "cooperative launch failed: %s (grid %d)\n", hipGetErrorString(e), grid_blocks);
}
```

```cpp
#include <hip/hip_runtime.h>
#include <hip/hip_cooperative_groups.h>
#include <cstdio>
#include <cstdint>
namespace cg = cooperative_groups;

typedef unsigned short u16;
typedef __attribute__((ext_vector_type(8))) __bf16 bf16x8;
typedef __attribute__((ext_vector_type(2))) __bf16 bf16x2;
typedef __attribute__((ext_vector_type(2))) float f32x2;
typedef __attribute__((ext_vector_type(16))) float f32x16;
typedef __attribute__((ext_vector_type(4))) unsigned int u32x4;
typedef __attribute__((ext_vector_type(2))) unsigned int u32x2;
typedef __attribute__((ext_vector_type(6))) unsigned int u32x6;
typedef __attribute__((ext_vector_type(3))) unsigned int u32x3;
typedef __attribute__((ext_vector_type(4))) float f32x4;
typedef __attribute__((ext_vector_type(32))) float f32x32;
typedef __attribute__((ext_vector_type(32))) __bf16 bf16x32;
typedef __attribute__((ext_vector_type(16))) unsigned int u32x16;

#define DEV __device__ __forceinline__
#define FP6_INTERLEAVED 1
#define GAS __attribute__((address_space(1)))

constexpr int DM = 1024;
constexpr int NTOK = 32768;
constexpr int NTILES = 256;
constexpr int NIN = 3584;
constexpr int NINP = 3616;
constexpr int NEXP = 16384;
constexpr int NT = 512;
constexpr float EPS = 1e-6f;

constexpr size_t MiB = 1024 * 1024;
constexpr size_t WS_WT_IN = 0;
constexpr size_t SZ_WT_IN1 = (size_t)NINP * 1024 * 2;
constexpr size_t WS_WT_OUT = WS_WT_IN + 2 * SZ_WT_IN1;
constexpr size_t WS_WT_XQ = WS_WT_OUT + 4 * MiB;
constexpr size_t WS_WT_XK = WS_WT_XQ + 4 * MiB;
constexpr size_t WS_WT_XV = WS_WT_XK + 4 * MiB;
constexpr size_t WS_WT_XO = WS_WT_XV + 4 * MiB;
constexpr size_t WS_WT_PQ = WS_WT_XO + 4 * MiB;
constexpr size_t WS_SKT = WS_WT_PQ + 8 * MiB;
constexpr size_t WS_MEMN = WS_SKT + 2 * MiB;
constexpr size_t WS_MEMK = WS_MEMN + 2 * MiB;
constexpr size_t WS_MEMVT = WS_MEMK + 2 * MiB;
constexpr size_t WS_GATES = WS_MEMVT + 2 * MiB;
constexpr size_t WS_BCUM = WS_GATES + 1 * MiB;
constexpr size_t WS_NLOC = WS_BCUM + 512 * 1024;
constexpr size_t WS_NSTATE = WS_NLOC + 512 * 1024;
constexpr size_t WS_MLOC = WS_NSTATE + 512 * 1024;
constexpr size_t WS_BL = WS_MLOC + 4096;
constexpr size_t WS_MSTATE = WS_BL + 4096;
constexpr size_t WS_HALO = WS_MSTATE + 4096;
constexpr size_t WS_Z = WS_HALO + 2 * MiB;
constexpr size_t WS_KT = WS_Z + (size_t)NTOK * NIN * 2;
constexpr size_t WS_VT = WS_KT + 32 * MiB;
constexpr size_t WS_KVLOC = WS_VT + 32 * MiB;
constexpr size_t WS_CSTATE = WS_KVLOC + 64 * MiB;
constexpr size_t WS_EXP6 = WS_CSTATE + 32 * MiB;
constexpr size_t WS_BAR = WS_EXP6 + 48 * MiB;
constexpr size_t WS_WT_MO = WS_BAR + 4096;
constexpr size_t WS_WT_MQ = WS_WT_MO + 8 * MiB;
constexpr size_t WS_END = WS_WT_MQ + 8 * MiB;

constexpr size_t ZSLOT = (size_t)128 * NIN * 2;
constexpr size_t R2_OFF = 0, R3_OFF = 256 * 1024, R4_OFF = 768 * 1024;

constexpr int LDS_BYTES = 131072 + 1024;

struct Params {
  const float *x, *mem, *g_mix, *w_in, *b_if, *conv_w, *conv_b, *g_head, *w_out, *g_xattn, *g_mem;
  const float *w_xq, *w_xk, *w_xv, *w_xo, *g_ffn, *w_pq, *sub_keys, *u_exp, *v_exp, *g_final;
  float* out;
  unsigned char* ws;
};

DEV int opaque_tid() { int t = threadIdx.x; asm volatile("" : "+v"(t)); return t; }
DEV unsigned char* opaque_ptr(unsigned char* q) { GAS unsigned char* g = (GAS unsigned char*)q; asm volatile("" : "+s"(g)); return (unsigned char*)g; }
DEV float bf2f(u16 v) { return __uint_as_float(((unsigned)v) << 16); }
DEV unsigned pk2(float lo, float hi) { f32x2 v = {lo, hi}; bf16x2 b = __builtin_convertvector(v, bf16x2); return __builtin_bit_cast(unsigned, b); }
DEV u16 f2bf(float f) { return (u16)(pk2(f, 0.f) & 0xffffu); }
template <int M> DEV float shx(float v) {
  if constexpr (M == 32) return __shfl_xor(v, 32);
  else return __builtin_bit_cast(float, __builtin_amdgcn_ds_swizzle(__builtin_bit_cast(int, v), (M << 10) | 0x1F));
}
DEV float shfl_idx(float v, int srclane) { return __builtin_bit_cast(float, __builtin_amdgcn_ds_bpermute(srclane << 2, __builtin_bit_cast(int, v))); }
DEV float wave_sum(float v) { v += shx<32>(v); v += shx<16>(v); v += shx<8>(v); v += shx<4>(v); v += shx<2>(v); v += shx<1>(v); return v; }
DEV float wave_max(float v) { v = fmaxf(v, shx<32>(v)); v = fmaxf(v, shx<16>(v)); v = fmaxf(v, shx<8>(v)); v = fmaxf(v, shx<4>(v)); v = fmaxf(v, shx<2>(v)); v = fmaxf(v, shx<1>(v)); return v; }
DEV __amdgpu_buffer_rsrc_t mkrsrc(const void* p) { return __builtin_amdgcn_make_buffer_rsrc((void*)p, 0, 0x7fffffff, 0x00020000); }
DEV int rowmap(int reg, int lane) { return (reg & 3) + 8 * (reg >> 2) + 4 * (lane >> 5); }
DEV f32x16 zero16() { f32x16 z;
#pragma unroll
  for (int i = 0; i < 16; ++i) z[i] = 0.f;
  return z; }
DEV bf16x8 ld_frag(const unsigned char* p) { return *(const bf16x8*)p; }
DEV bf16x8 ld_frag_g(const u16* p) { uint4 v = *(const uint4*)p; return __builtin_bit_cast(bf16x8, v); }
DEV float bflo(unsigned w) { return __uint_as_float(w << 16); }
DEV float bfhi(unsigned w) { return __uint_as_float(w & 0xffff0000u); }

DEV void rmsnorm_tile(const float* src, const float* g, u16* dst) {
  const int tid = opaque_tid(), wave = tid >> 6, lane = tid & 63;
  const float4* gr = (const float4*)g + lane;
  float4 gg[4];
#pragma unroll
  for (int j = 0; j < 4; ++j) gg[j] = gr[64 * j];
#pragma unroll 1
  for (int r0 = wave * 16; r0 < wave * 16 + 16; r0 += 4) {
    float4 v[4][4]; float ss[4];
#pragma unroll
    for (int q = 0; q < 4; ++q) {
      const float4* xr = (const float4*)(src + (size_t)(r0 + q) * DM) + lane;
#pragma unroll
      for (int j = 0; j < 4; ++j) v[q][j] = xr[64 * j];
    }
#pragma unroll
    for (int q = 0; q < 4; ++q) {
      float s = 0.f;
#pragma unroll
      for (int j = 0; j < 4; ++j) s += v[q][j].x * v[q][j].x + v[q][j].y * v[q][j].y + v[q][j].z * v[q][j].z + v[q][j].w * v[q][j].w;
      ss[q] = s;
    }
#pragma unroll
    for (int q = 0; q < 4; ++q) ss[q] = wave_sum(ss[q]);
#pragma unroll
    for (int q = 0; q < 4; ++q) {
      const float rs = rsqrtf(ss[q] * (1.f / DM) + EPS);
      uint2* o = (uint2*)(dst + (size_t)(r0 + q) * DM) + lane;
#pragma unroll
      for (int j = 0; j < 4; ++j) o[64 * j] = make_uint2(pk2(v[q][j].x * rs * gg[j].x, v[q][j].y * rs * gg[j].y), pk2(v[q][j].z * rs * gg[j].z, v[q][j].w * rs * gg[j].w));
    }
  }
}

struct TileDesc { const u16* A; int lda; const u16* B; int ldb; int kb; };
constexpr int G_STAGE = 55296, G_BOFF = 18432, G_PITCH = 144;

#define GEMM_LOAD(ra, rb, s_)                                                                                  \
  {                                                                                                            \
    const int j_ = (s_) / KS, kk_ = (s_) % KS;                                                                  \
    const TileDesc d_ = descf(j_);                                                                              \
    const __amdgpu_buffer_rsrc_t rsA_ = mkrsrc(d_.A), rsB_ = mkrsrc(d_.B);                                      \
    const int voA_ = ((tid >> 3) * d_.lda + (tid & 7) * 8) * 2, voB_ = ((tid >> 3) * d_.ldb + (tid & 7) * 8) * 2; \
    _Pragma("unroll") for (int i = 0; i < 2; ++i) ra[i] = __builtin_amdgcn_raw_buffer_load_b128(rsA_, voA_, (kk_ * 64 + i * 64 * d_.lda) * 2, 0); \
    _Pragma("unroll") for (int i = 0; i < 4; ++i) rb[i] = __builtin_amdgcn_raw_buffer_load_b128(rsB_, voB_, (kk_ * 64 + i * 64 * d_.ldb) * 2, 0); \
  }
#define GEMM_STORE(ra, rb, buf_)                                                                               \
  {                                                                                                            \
    unsigned char* base_ = lds + (buf_) * G_STAGE + (tid >> 3) * G_PITCH + (tid & 7) * 16;                      \
    _Pragma("unroll") for (int i = 0; i < 2; ++i) *(u32x4*)(base_ + i * 64 * G_PITCH) = ra[i];                  \
    _Pragma("unroll") for (int i = 0; i < 4; ++i) *(u32x4*)(base_ + G_BOFF + i * 64 * G_PITCH) = rb[i];         \
  }
#define GEMM_COMPUTE(buf_)                                                                                     \
  {                                                                                                            \
    const unsigned char* st = lds + (buf_) * G_STAGE;                                                           \
    _Pragma("unroll") for (int ks = 0; ks < 4; ++ks) {                                                          \
      const bf16x8 a0 = ld_frag(st + aoff + ks * 32), a1 = ld_frag(st + aoff + 32 * G_PITCH + ks * 32);         \
      const bf16x8 b0 = ld_frag(st + boff + ks * 32), b1 = ld_frag(st + boff + 32 * G_PITCH + ks * 32);         \
      acc[0][0] = __builtin_amdgcn_mfma_f32_32x32x16_bf16(a0, b0, acc[0][0], 0, 0, 0);                          \
      acc[0][1] = __builtin_amdgcn_mfma_f32_32x32x16_bf16(a0, b1, acc[0][1], 0, 0, 0);                          \
      acc[1][0] = __builtin_amdgcn_mfma_f32_32x32x16_bf16(a1, b0, acc[1][0], 0, 0, 0);                          \
      acc[1][1] = __builtin_amdgcn_mfma_f32_32x32x16_bf16(a1, b1, acc[1][1], 0, 0, 0);                          \
    }                                                                                                           \
  }
#define GEMM_EPI(s_)                                                                                           \
  if (((s_) % KS) == KS - 1) {                                                                                 \
    epif((s_) / KS, acc, wm, wn, lane);                                                                         \
    _Pragma("unroll") for (int a = 0; a < 2; ++a) _Pragma("unroll") for (int b = 0; b < 2; ++b) acc[a][b] = zero16(); \
  }

#define LC_LOAD(ra, rb, s_)                                                                                    \
  {                                                                                                            \
    const int j_ = (s_) / KS, kk_ = ((s_) + krot) % KS;                                                                  \
    const TileDesc d_ = descf(j_);                                                                              \
    const __amdgpu_buffer_rsrc_t rsA_ = mkrsrc(d_.A), rsB_ = mkrsrc(d_.B);                                      \
    const int voA_ = ((lt >> 3) * d_.lda + (lt & 7) * 8) * 2, voB_ = ((lt >> 3) * d_.ldb + (lt & 7) * 8) * 2;   \
    _Pragma("unroll") for (int i = 0; i < 4; ++i) ra[i] = __builtin_amdgcn_raw_buffer_load_b128(rsA_, voA_, (kk_ * 64 + ((i + rot) & 3) * 32 * d_.lda) * 2, 0); \
    _Pragma("unroll") for (int i = 0; i < 8; ++i) rb[i] = __builtin_amdgcn_raw_buffer_load_b128(rsB_, voB_, (kk_ * d_.kb + ((i + rot) & 7) * 32 * d_.ldb) * 2, 0); \
  }
#define LC_LOADC(ra, rb, s_) { const int sn_ = ((s_) < total) ? (s_) : total - 1; LC_LOAD(ra, rb, sn_); }
#define LC_STORE(ra, rb, buf_)                                                                                 \
  {                                                                                                            \
    unsigned char* base_ = lds + (buf_) * G_STAGE + (lt >> 3) * G_PITCH + (lt & 7) * 16;                        \
    _Pragma("unroll") for (int i = 0; i < 4; ++i) *(u32x4*)(base_ + ((i + rot) & 3) * 32 * G_PITCH) = ra[i];                  \
    _Pragma("unroll") for (int i = 0; i < 8; ++i) *(u32x4*)(base_ + G_BOFF + ((i + rot) & 7) * 32 * G_PITCH) = rb[i];         \
  }
#define LC_COMPUTE(buf_)                                                                                       \
  {                                                                                                            \
    const unsigned char* st = lds + (buf_) * G_STAGE;                                                           \
    _Pragma("unroll") for (int ks = 0; ks < 4; ++ks) {                                                          \
      const bf16x8 a0 = ld_frag(st + aoff + ks * 32), a1 = ld_frag(st + aoff + 32 * G_PITCH + ks * 32);         \
      _Pragma("unroll") for (int ni = 0; ni < 4; ++ni) {                                                        \
        const bf16x8 b = ld_frag(st + boff + ni * 32 * G_PITCH + ks * 32);                                      \
        if constexpr (SW) { acc[0][ni] = __builtin_amdgcn_mfma_f32_32x32x16_bf16(b, a0, acc[0][ni], 0, 0, 0); acc[1][ni] = __builtin_amdgcn_mfma_f32_32x32x16_bf16(b, a1, acc[1][ni], 0, 0, 0); } \
        else { acc[0][ni] = __builtin_amdgcn_mfma_f32_32x32x16_bf16(a0, b, acc[0][ni], 0, 0, 0); acc[1][ni] = __builtin_amdgcn_mfma_f32_32x32x16_bf16(a1, b, acc[1][ni], 0, 0, 0); } \
      }                                                                                                         \
    }                                                                                                           \
  }
#define LC_EPI(s_)                                                                                             \
  if (((s_) % KS) == KS - 1) {                                                                                 \
    epif((s_) / KS, acc, wm, wn, lane);                                                                         \
    _Pragma("unroll") for (int a = 0; a < 2; ++a) _Pragma("unroll") for (int b = 0; b < 4; ++b) acc[a][b] = zero16(); \
  }
#define LDS_BARRIER() do { asm volatile("s_waitcnt lgkmcnt(0)" ::: "memory"); __builtin_amdgcn_s_barrier(); asm volatile("" ::: "memory"); } while (0)

template <int KS, int EB = 0, bool SW = false, class DescF, class EpiF>
DEV void gemm_run(unsigned char* lds, int ntiles, DescF descf, EpiF epif) {
  const int tid = opaque_tid(), lane = tid & 63, wave = __builtin_amdgcn_readfirstlane(tid >> 6);
  const int total = ntiles * KS;
  __syncthreads();
  if (wave >= 4) {
    const int lt = tid - 256;
    const int krot = (5 * (__builtin_amdgcn_readfirstlane((int)blockIdx.x) >> 3) + (__builtin_amdgcn_readfirstlane((int)blockIdx.x) & 7)) & (KS - 1);
    const int rot = __builtin_amdgcn_readfirstlane((int)blockIdx.x) & 7;
    u32x4 ra0[4], rb0[8], ra1[4], rb1[8], ra2[4], rb2[8], ra3[4], rb3[8];
    LC_LOAD(ra0, rb0, 0);
    LC_LOAD(ra1, rb1, 1);
    LC_LOAD(ra2, rb2, 2);
    LC_LOAD(ra3, rb3, 3);
    LC_STORE(ra0, rb0, 0);
    LC_LOADC(ra0, rb0, 4);
    LDS_BARRIER();
#pragma unroll 1
    for (int s = 0; s < total; s += 4) {
#define LC_EB(s_) if (EB > 0 && ((s_) % KS) == KS - 1) { _Pragma("unroll") for (int eb = 0; eb < EB; ++eb) LDS_BARRIER(); }
      LC_STORE(ra1, rb1, 1); LC_LOADC(ra1, rb1, s + 5); LC_EB(s);     LDS_BARRIER();
      LC_STORE(ra2, rb2, 0); LC_LOADC(ra2, rb2, s + 6); LC_EB(s + 1); LDS_BARRIER();
      LC_STORE(ra3, rb3, 1); LC_LOADC(ra3, rb3, s + 7); LC_EB(s + 2); LDS_BARRIER();
      LC_STORE(ra0, rb0, 0); LC_LOADC(ra0, rb0, s + 8); LC_EB(s + 3); LDS_BARRIER();
#undef LC_EB
    }
  } else {
    const int wm = wave >> 1, wn = wave & 1;
    f32x16 acc[2][4];
#pragma unroll
    for (int a = 0; a < 2; ++a)
#pragma unroll
      for (int b = 0; b < 4; ++b) acc[a][b] = zero16();
    const int aoff = (wm * 64 + (lane & 31)) * G_PITCH + (lane >> 5) * 16;
    const int boff = G_BOFF + (wn * 128 + (lane & 31)) * G_PITCH + (lane >> 5) * 16;
    LDS_BARRIER();
    __builtin_amdgcn_s_setprio(2);
#pragma unroll 1
    for (int s = 0; s < total; s += 2) {
      LC_COMPUTE(0); LC_EPI(s);     LDS_BARRIER();
      LC_COMPUTE(1); LC_EPI(s + 1); LDS_BARRIER();
    }
    __builtin_amdgcn_s_setprio(0);
  }
  __syncthreads();
}

DEV void epi_store_bf16(const f32x16 (&acc)[2][4], int wm, int wn, int lane, u16* dst, int ld, int col0, float scale) {
  const __amdgpu_buffer_rsrc_t rs = mkrsrc(dst);
  const int voff = (4 * (lane >> 5) * ld + (lane & 31)) * 2;
#pragma unroll
  for (int mi = 0; mi < 2; ++mi)
#pragma unroll
    for (int ni = 0; ni < 4; ++ni)
#pragma unroll
      for (int r = 0; r < 16; ++r) {
        const int soff = ((wm * 64 + mi * 32 + (r & 3) + 8 * (r >> 2)) * ld + col0 + wn * 128 + ni * 32) * 2;
        __builtin_amdgcn_raw_buffer_store_b16(f2bf(acc[mi][ni][r] * scale), rs, voff, soff, 0);
      }
}
DEV void epi_store_u(const f32x16 (&acc)[2][4], int wm, int wn, int lane, u16* dst, int ld, int ucol0) {
  const __amdgpu_buffer_rsrc_t rs = mkrsrc(dst);
  const int voff = (4 * (lane >> 5) * ld + (lane & 31)) * 2;
#pragma unroll
  for (int mi = 0; mi < 2; ++mi)
#pragma unroll
    for (int pp = 0; pp < 2; ++pp)
#pragma unroll
      for (int r = 0; r < 16; ++r) {
        const int soff = ((wm * 64 + mi * 32 + (r & 3) + 8 * (r >> 2)) * ld + ucol0 + wn * 64 + pp * 32) * 2;
        __builtin_amdgcn_raw_buffer_store_b16(f2bf(acc[mi][2 * pp][r] * acc[mi][2 * pp + 1][r]), rs, voff, soff, 0);
      }
}
DEV void epi_store_f32(const f32x16 (&acc)[2][4], int wm, int wn, int lane, float* dst, int ld, int col0, float scale) {
  const __amdgpu_buffer_rsrc_t rs = mkrsrc(dst);
  const int voff = (4 * (lane >> 5) * ld + (lane & 31)) * 4;
#pragma unroll
  for (int mi = 0; mi < 2; ++mi)
#pragma unroll
    for (int ni = 0; ni < 4; ++ni)
#pragma unroll
      for (int r = 0; r < 16; ++r) {
        const int soff = ((wm * 64 + mi * 32 + (r & 3) + 8 * (r >> 2)) * ld + col0 + wn * 128 + ni * 32) * 4;
        __builtin_amdgcn_raw_buffer_store_b32(__float_as_uint(acc[mi][ni][r] * scale), rs, voff, soff, 0);
      }
}
DEV void epi_residual_norm(const f32x16 (&acc)[2][4], int wm, int wn, int lane, const void* src, bool src32, u16* dst, int col0, const float* g, u16* xg, float* rowss) {
  const __amdgpu_buffer_rsrc_t rsS = mkrsrc(src), rsD = mkrsrc(dst), rsX = mkrsrc(xg);
  const int voff = (4 * (lane >> 5) * DM + (lane & 31)) * 4;
  const int voffx = (4 * (lane >> 5) * DM + (lane & 31)) * 2;
#pragma unroll
  for (int mi = 0; mi < 2; ++mi) {
    float s[16];
#pragma unroll
    for (int ni = 0; ni < 4; ++ni) {
      float xv[16];
      const float gq = xg ? g[col0 + wn * 128 + ni * 32 + (lane & 31)] : 0.f;
      if (src32) {
#pragma unroll
        for (int r = 0; r < 16; ++r) {
          const int soff = ((wm * 64 + mi * 32 + (r & 3) + 8 * (r >> 2)) * DM + col0 + wn * 128 + ni * 32) * 4;
          xv[r] = __uint_as_float(__builtin_amdgcn_raw_buffer_load_b32(rsS, voff, soff, 0));
        }
      } else {
#pragma unroll
        for (int r = 0; r < 16; ++r) {
          const int soff = ((wm * 64 + mi * 32 + (r & 3) + 8 * (r >> 2)) * DM + col0 + wn * 128 + ni * 32) * 2;
          xv[r] = bf2f((u16)__builtin_amdgcn_raw_buffer_load_b16(rsS, voffx, soff, 0));
        }
      }
#pragma unroll
      for (int r = 0; r < 16; ++r) {
        const float v0 = xv[r] + acc[mi][ni][r];
        const int so = ((wm * 64 + mi * 32 + (r & 3) + 8 * (r >> 2)) * DM + col0 + wn * 128 + ni * 32);
        __builtin_amdgcn_raw_buffer_store_b16(f2bf(v0), rsD, voffx, so * 2, 0);
        if (xg) __builtin_amdgcn_raw_buffer_store_b16(f2bf(v0 * gq), rsX, voffx, so * 2, 0);
        s[r] = ni ? s[r] + v0 * v0 : v0 * v0;
      }
    }
    float t8[8], t4[4], t2[2], t1;
    const bool b4 = (lane & 16) != 0, b3 = (lane & 8) != 0, b2 = (lane & 4) != 0, b1 = (lane & 2) != 0;
#pragma unroll
    for (int q = 0; q < 8; ++q) { const float snd = b4 ? s[q] : s[q + 8], kp = b4 ? s[q + 8] : s[q]; t8[q] = kp + shx<16>(snd); }
#pragma unroll
    for (int q = 0; q < 4; ++q) { const float snd = b3 ? t8[q] : t8[q + 4], kp = b3 ? t8[q + 4] : t8[q]; t4[q] = kp + shx<8>(snd); }
#pragma unroll
    for (int q = 0; q < 2; ++q) { const float snd = b2 ? t4[q] : t4[q + 2], kp = b2 ? t4[q + 2] : t4[q]; t2[q] = kp + shx<4>(snd); }
    { const float snd = b1 ? t2[0] : t2[1], kp = b1 ? t2[1] : t2[0]; t1 = kp + shx<2>(snd); }
    t1 += shx<1>(t1);
    if ((lane & 1) == 0) {
      const int r = (lane >> 1) & 15;
      rowss[((col0 >> 8) * 2 + wn) * 128 + wm * 64 + mi * 32 + (r & 3) + 8 * (r >> 2) + 4 * (lane >> 5)] = t1;
    }
  }
}
DEV void epi_store_bf16_rows(const f32x16 (&acc)[2][4], int wm, int wn, int lane, u16* dst, int ld, int col0, const float* rsv) {
  const __amdgpu_buffer_rsrc_t rs = mkrsrc(dst);
  const int voff = (4 * (lane >> 5) * ld + (lane & 31)) * 2;
#pragma unroll
  for (int mi = 0; mi < 2; ++mi)
#pragma unroll
    for (int g = 0; g < 4; ++g) {
      const float4 sc4 = *(const float4*)(rsv + wm * 64 + mi * 32 + 8 * g + 4 * (lane >> 5));
      const float sc[4] = {sc4.x, sc4.y, sc4.z, sc4.w};
#pragma unroll
      for (int ni = 0; ni < 4; ++ni)
#pragma unroll
        for (int e = 0; e < 4; ++e) {
          const int soff = ((wm * 64 + mi * 32 + 8 * g + e) * ld + col0 + wn * 128 + ni * 32) * 2;
          __builtin_amdgcn_raw_buffer_store_b16(f2bf(acc[mi][ni][4 * g + e] * sc[e]), rs, voff, soff, 0);
        }
    }
}
DEV void epi_store_f32_rows(const f32x16 (&acc)[2][4], int wm, int wn, int lane, float* dst, int ld, int col0, const float* rsv) {
  const __amdgpu_buffer_rsrc_t rs = mkrsrc(dst);
  const int voff = (4 * (lane >> 5) * ld + (lane & 31)) * 4;
#pragma unroll
  for (int mi = 0; mi < 2; ++mi)
#pragma unroll
    for (int g = 0; g < 4; ++g) {
      const float4 sc4 = *(const float4*)(rsv + wm * 64 + mi * 32 + 8 * g + 4 * (lane >> 5));
      const float sc[4] = {sc4.x, sc4.y, sc4.z, sc4.w};
#pragma unroll
      for (int ni = 0; ni < 4; ++ni)
#pragma unroll
        for (int e = 0; e < 4; ++e) {
          const int soff = ((wm * 64 + mi * 32 + 8 * g + e) * ld + col0 + wn * 128 + ni * 32) * 4;
          __builtin_amdgcn_raw_buffer_store_b32(__float_as_uint(acc[mi][ni][4 * g + e] * sc[e]), rs, voff, soff, 0);
        }
    }
}
DEV void epi_store_bf16_T(const f32x16 (&acc)[2][4], int wm, int wn, int lane, u16* dst, int ldt, int colbase) {
  const __amdgpu_buffer_rsrc_t rs = mkrsrc(dst);
  const int voff = ((lane & 31) * ldt + 4 * (lane >> 5)) * 2;
#pragma unroll
  for (int mi = 0; mi < 2; ++mi)
#pragma unroll
    for (int ni = 0; ni < 4; ++ni)
#pragma unroll
      for (int g = 0; g < 4; ++g) {
        const int soff = ((colbase + wn * 128 + ni * 32) * ldt + wm * 64 + mi * 32 + 8 * g) * 2;
        u32x2 v; v.x = pk2(acc[mi][ni][4 * g], acc[mi][ni][4 * g + 1]); v.y = pk2(acc[mi][ni][4 * g + 2], acc[mi][ni][4 * g + 3]);
        __builtin_amdgcn_raw_buffer_store_b64(v, rs, voff, soff, 0);
      }
}

DEV void epi_store_tiled(const f32x16 (&acc)[2][4], int wm, int wn, int lane, u16* dst, int jn, int nbase, int kcol0, float scale) {
  const __amdgpu_buffer_rsrc_t rs = mkrsrc(dst);
  const int voff = (4 * (lane >> 5) * 64 + (lane & 31)) * 2;
#pragma unroll
  for (int mi = 0; mi < 2; ++mi)
#pragma unroll
    for (int ni = 0; ni < 4; ++ni)
#pragma unroll
      for (int r = 0; r < 16; ++r) {
        const int kc = kcol0 + wn * 128 + ni * 32;
        const int soff = ((jn * 16 + (kc >> 6)) * 16384 + (nbase + wm * 64 + mi * 32 + (r & 3) + 8 * (r >> 2)) * 64 + (kc & 63)) * 2;
        __builtin_amdgcn_raw_buffer_store_b16(f2bf(acc[mi][ni][r] * scale), rs, voff, soff, 0);
      }
}
DEV void epi_store_tiledT(const f32x16 (&acc)[2][4], int wm, int wn, int lane, u16* dst, int jn, int kbase) {
  const __amdgpu_buffer_rsrc_t rs = mkrsrc(dst);
  const int voff = ((lane & 31) * 64 + 4 * (lane >> 5)) * 2;
#pragma unroll
  for (int mi = 0; mi < 2; ++mi)
#pragma unroll
    for (int ni = 0; ni < 4; ++ni)
#pragma unroll
      for (int g = 0; g < 4; ++g) {
        const int k0 = kbase + wm * 64 + mi * 32 + 8 * g;
        const int soff = ((jn * 16 + (k0 >> 6)) * 16384 + (wn * 128 + ni * 32) * 64 + (k0 & 63)) * 2;
        u32x2 v; v.x = pk2(acc[mi][ni][4 * g], acc[mi][ni][4 * g + 1]); v.y = pk2(acc[mi][ni][4 * g + 2], acc[mi][ni][4 * g + 3]);
        __builtin_amdgcn_raw_buffer_store_b64(v, rs, voff, soff, 0);
      }
}

DEV void epi_softmax_bf16(const f32x16 (&acc)[2][4], int wm, int wn, int lane, u16* dst, int ld, int col0, const float* rsv, float* pm, float* ps) {
  const bool b4 = (lane & 16) != 0, b3 = (lane & 8) != 0, b2 = (lane & 4) != 0, b1 = (lane & 2) != 0;
  const int rsel = (lane >> 1) & 15;
  const int rrow = (rsel & 3) + 8 * (rsel >> 2) + 4 * (lane >> 5);
  float rsf[2][16];
#pragma unroll
  for (int mi = 0; mi < 2; ++mi)
#pragma unroll
    for (int g = 0; g < 4; ++g) {
      const float4 s4 = *(const float4*)(rsv + wm * 64 + mi * 32 + 8 * g + 4 * (lane >> 5));
      rsf[mi][4 * g] = s4.x; rsf[mi][4 * g + 1] = s4.y; rsf[mi][4 * g + 2] = s4.z; rsf[mi][4 * g + 3] = s4.w;
    }
#pragma unroll
  for (int mi = 0; mi < 2; ++mi) {
    float s[16];
#pragma unroll
    for (int r = 0; r < 16; ++r) s[r] = fmaxf(fmaxf(acc[mi][0][r], acc[mi][1][r]), fmaxf(acc[mi][2][r], acc[mi][3][r])) * rsf[mi][r];
    float t8[8], t4[4], t2[2], t1;
#pragma unroll
    for (int q = 0; q < 8; ++q) { const float snd = b4 ? s[q] : s[q + 8], kp = b4 ? s[q + 8] : s[q]; t8[q] = fmaxf(kp, shx<16>(snd)); }
#pragma unroll
    for (int q = 0; q < 4; ++q) { const float snd = b3 ? t8[q] : t8[q + 4], kp = b3 ? t8[q + 4] : t8[q]; t4[q] = fmaxf(kp, shx<8>(snd)); }
#pragma unroll
    for (int q = 0; q < 2; ++q) { const float snd = b2 ? t4[q] : t4[q + 2], kp = b2 ? t4[q + 2] : t4[q]; t2[q] = fmaxf(kp, shx<4>(snd)); }
    { const float snd = b1 ? t2[0] : t2[1], kp = b1 ? t2[1] : t2[0]; t1 = fmaxf(kp, shx<2>(snd)); }
    t1 = fmaxf(t1, shx<1>(t1));
    if ((lane & 1) == 0) pm[wn * 128 + wm * 64 + mi * 32 + rrow] = t1;
  }
  LDS_BARRIER();
#pragma unroll
  for (int mi = 0; mi < 2; ++mi) {
    float s[16];
#pragma unroll
    for (int g = 0; g < 4; ++g) {
      const int rb = wm * 64 + mi * 32 + 8 * g + 4 * (lane >> 5);
      const float4 m0 = *(const float4*)(pm + rb), m1 = *(const float4*)(pm + 128 + rb);
      const float mx[4] = {fmaxf(m0.x, m1.x), fmaxf(m0.y, m1.y), fmaxf(m0.z, m1.z), fmaxf(m0.w, m1.w)};
#pragma unroll
      for (int q = 0; q < 4; ++q) {
        float e = 0.f;
#pragma unroll
        for (int ni = 0; ni < 4; ++ni) e += __expf(acc[mi][ni][4 * g + q] * rsf[mi][4 * g + q] - mx[q]);
        s[4 * g + q] = e;
      }
    }
    float t8[8], t4[4], t2[2], t1;
#pragma unroll
    for (int q = 0; q < 8; ++q) { const float snd = b4 ? s[q] : s[q + 8], kp = b4 ? s[q + 8] : s[q]; t8[q] = kp + shx<16>(snd); }
#pragma unroll
    for (int q = 0; q < 4; ++q) { const float snd = b3 ? t8[q] : t8[q + 4], kp = b3 ? t8[q + 4] : t8[q]; t4[q] = kp + shx<8>(snd); }
#pragma unroll
    for (int q = 0; q < 2; ++q) { const float snd = b2 ? t4[q] : t4[q + 2], kp = b2 ? t4[q + 2] : t4[q]; t2[q] = kp + shx<4>(snd); }
    { const float snd = b1 ? t2[0] : t2[1], kp = b1 ? t2[1] : t2[0]; t1 = kp + shx<2>(snd); }
    t1 += shx<1>(t1);
    if ((lane & 1) == 0) ps[wn * 128 + wm * 64 + mi * 32 + rrow] = t1;
  }
  LDS_BARRIER();
  const __amdgpu_buffer_rsrc_t rs = mkrsrc(dst);
  const int voff = (4 * (lane >> 5) * ld + (lane & 31)) * 2;
#pragma unroll
  for (int mi = 0; mi < 2; ++mi)
#pragma unroll
    for (int g = 0; g < 4; ++g) {
      const int rb = wm * 64 + mi * 32 + 8 * g + 4 * (lane >> 5);
      const float4 m0 = *(const float4*)(pm + rb), m1 = *(const float4*)(pm + 128 + rb);
      const float mx[4] = {fmaxf(m0.x, m1.x), fmaxf(m0.y, m1.y), fmaxf(m0.z, m1.z), fmaxf(m0.w, m1.w)};
      const float4 s0 = *(const float4*)(ps + rb), s1 = *(const float4*)(ps + 128 + rb);
      const float inv[4] = {1.f / (s0.x + s1.x), 1.f / (s0.y + s1.y), 1.f / (s0.z + s1.z), 1.f / (s0.w + s1.w)};
#pragma unroll
      for (int ni = 0; ni < 4; ++ni)
#pragma unroll
        for (int q = 0; q < 4; ++q) {
          const int soff = ((wm * 64 + mi * 32 + 8 * g + q) * ld + col0 + wn * 128 + ni * 32) * 2;
          __builtin_amdgcn_raw_buffer_store_b16(f2bf(__expf(acc[mi][ni][4 * g + q] * rsf[mi][4 * g + q] - mx[q]) * inv[q]), rs, voff, soff, 0);
        }
    }
  LDS_BARRIER();
}

DEV void transpose_item(const float* W, int N, u16* WT, float* scr, int item, int nblk, int lane, bool inmap = false) {
  const int kb = item / nblk, nb = item % nblk, k0 = 64 * kb, n0 = 32 * nb;
  int ns = n0;
  if (inmap) {
    if (nb < 32) { const int q = nb & 7, c0 = (nb >> 3) * 128 + (q >> 2) * 64 + ((q & 3) >> 1) * 32; ns = (q & 1) ? 1024 + c0 : c0; }
    else if (nb < 48) ns = 512 + (nb - 32) * 32;
  }
  const int kq = lane >> 3, nq = (lane & 7) * 4;
  float4 v[8];
#pragma unroll
  for (int i = 0; i < 8; ++i) v[i] = (ns + nq < N) ? *(const float4*)(W + (size_t)(k0 + 8 * i + kq) * N + ns + nq) : make_float4(0.f, 0.f, 0.f, 0.f);
#pragma unroll
  for (int i = 0; i < 8; ++i) { float* d = scr + (8 * i + kq) * 33 + nq; d[0] = v[i].x; d[1] = v[i].y; d[2] = v[i].z; d[3] = v[i].w; }
  const int c = lane & 7;
#pragma unroll
  for (int j = 0; j < 4; ++j) {
    const int nn = (lane >> 3) + 8 * j; const float* s = scr + (8 * c) * 33 + nn;
    uint4 o; o.x = pk2(s[0 * 33], s[1 * 33]); o.y = pk2(s[2 * 33], s[3 * 33]); o.z = pk2(s[4 * 33], s[5 * 33]); o.w = pk2(s[6 * 33], s[7 * 33]);
    const int n = n0 + nn;
    const size_t off = (n < (N & ~255)) ? ((size_t)((n >> 8) * 16 + (k0 >> 6)) * 16384 + (size_t)(n & 255) * 64 + 8 * c) : ((size_t)n * 1024 + k0 + 8 * c);
    *(uint4*)(WT + off) = o;
  }
}

DEV void fold_item(const float* W, const float* SK, u16* WT, float* scr, int item, int lane) {
  const int kb = item >> 6, nb = item & 63, k0 = 64 * kb, n0 = 32 * nb;
  const int kq = lane >> 3, nq = (lane & 7) * 4;
  const int blk = n0 >> 7, key0 = (n0 & 127) + nq;
  const float* wp = W + (size_t)(k0 + kq) * 2048 + blk * 128;
  const float* sp = SK + ((size_t)blk * 128 + key0) * 128;
  float o[8][4];
#pragma unroll
  for (int i = 0; i < 8; ++i)
#pragma unroll
    for (int e = 0; e < 4; ++e) o[i][e] = 0.f;
#pragma unroll 2
  for (int c4 = 0; c4 < 32; ++c4) {
    float4 wv[8], sv[4];
#pragma unroll
    for (int i = 0; i < 8; ++i) wv[i] = *(const float4*)(wp + (size_t)(8 * i) * 2048 + 4 * c4);
#pragma unroll
    for (int e = 0; e < 4; ++e) sv[e] = *(const float4*)(sp + e * 128 + 4 * c4);
#pragma unroll
    for (int i = 0; i < 8; ++i)
#pragma unroll
      for (int e = 0; e < 4; ++e) o[i][e] += (wv[i].x * sv[e].x + wv[i].y * sv[e].y) + (wv[i].z * sv[e].z + wv[i].w * sv[e].w);
  }
#pragma unroll
  for (int i = 0; i < 8; ++i) { float* d = scr + (8 * i + kq) * 33 + nq; d[0] = o[i][0]; d[1] = o[i][1]; d[2] = o[i][2]; d[3] = o[i][3]; }
  const int c = lane & 7;
#pragma unroll
  for (int j = 0; j < 4; ++j) {
    const int nn = (lane >> 3) + 8 * j; const float* s = scr + (8 * c) * 33 + nn;
    uint4 ov; ov.x = pk2(s[0 * 33], s[1 * 33]); ov.y = pk2(s[2 * 33], s[3 * 33]); ov.z = pk2(s[4 * 33], s[5 * 33]); ov.w = pk2(s[6 * 33], s[7 * 33]);
    const int n = n0 + nn;
    *(uint4*)(WT + (size_t)((n >> 8) * 16 + kb) * 16384 + (size_t)(n & 255) * 64 + 8 * c) = ov;
  }
}

DEV void phase0(const Params& p, unsigned char* lds) {
  const int tid = opaque_tid(), lane = tid & 63, wave = tid >> 6;
  const int gw = blockIdx.x * 8 + wave, NGW = gridDim.x * 8;
  float* scr = (float*)(lds + wave * 8704);
  unsigned char* ws = p.ws;
  constexpr int I_IN = 16 * 113, I_SQ = 16 * 32, I_PQ = 16 * 64;
  constexpr int IPL = I_IN + 5 * I_SQ + I_PQ;
  for (int it = gw; it < 2 * IPL; it += NGW) {
    const int l = it / IPL; int r = it % IPL;
    if (r < I_IN) { transpose_item(p.w_in + (size_t)l * 1024 * 3592, 3592, (u16*)(ws + WS_WT_IN + l * SZ_WT_IN1), scr, r, 113, lane, true); continue; } r -= I_IN;
    if (r < I_SQ) { transpose_item(p.w_out + (size_t)l * DM * DM, 1024, (u16*)(ws + WS_WT_OUT + l * 2 * MiB), scr, r, 32, lane); continue; } r -= I_SQ;
    if (r < I_SQ) {
      const float4* s4 = (const float4*)(p.w_xq + (size_t)l * DM * DM) + (size_t)r * 512 + lane;
      uint2* d2 = (uint2*)(ws + WS_WT_XQ + l * 2 * MiB) + (size_t)r * 512 + lane;
#pragma unroll
      for (int i = 0; i < 8; ++i) { const float gk = p.g_xattn[l * DM + 2 * r + (i >> 2)];
        const float4 f = s4[64 * i]; d2[64 * i] = make_uint2(pk2(f.x * gk, f.y * gk), pk2(f.z * gk, f.w * gk)); }
      continue; } r -= I_SQ;
    if (r < I_SQ) { transpose_item(p.w_xk + (size_t)l * DM * DM, 1024, (u16*)(ws + WS_WT_XK + l * 2 * MiB), scr, r, 32, lane); continue; } r -= I_SQ;
    if (r < I_SQ) { transpose_item(p.w_xv + (size_t)l * DM * DM, 1024, (u16*)(ws + WS_WT_XV + l * 2 * MiB), scr, r, 32, lane); continue; } r -= I_SQ;
    if (r < I_SQ) { transpose_item(p.w_xo + (size_t)l * DM * DM, 1024, (u16*)(ws + WS_WT_XO + l * 2 * MiB), scr, r, 32, lane); continue; } r -= I_SQ;
    fold_item(p.w_pq + (size_t)l * DM * 2048, p.sub_keys + (size_t)l * 16 * 128 * 128, (u16*)(ws + WS_WT_PQ + l * 4 * MiB), scr, r, lane);
  }
  {
    unsigned char* e6 = ws + WS_EXP6;
    const int hl = lane & 31, q = hl & 15, c0 = 2 * (hl >> 4);
    for (int rp = gw; rp < 2 * NEXP; rp += NGW) {
      const int row = rp * 2 + (lane >> 5);
      const int l = row >> 15, uv = (row >> 14) & 1, e = row & (NEXP - 1);
      const float* srcp = (uv ? p.v_exp : p.u_exp) + ((size_t)l * NEXP + e) * DM;
      const float scl = uv ? 6.f : 48.f;
      f32x16 fa, fb;
#pragma unroll
      for (int j = 0; j < 8; ++j) {
        float4 f = ((const float4*)srcp)[64 * (c0 + (j >> 2)) + q + 16 * (j & 3)];
        f.x = fminf(fmaxf(f.x * scl, -7.5f), 7.5f); f.y = fminf(fmaxf(f.y * scl, -7.5f), 7.5f);
        f.z = fminf(fmaxf(f.z * scl, -7.5f), 7.5f); f.w = fminf(fmaxf(f.w * scl, -7.5f), 7.5f);
        fa[2 * j] = f.x; fb[2 * j] = f.y; fa[2 * j + 1] = f.z; fb[2 * j + 1] = f.w;
      }
      const u32x6 o = __builtin_amdgcn_cvt_scalef32_2xpk16_fp6_f32(fa, fb, 1.0f);
      unsigned char* dst = e6 + (size_t)(l * 2 + uv) * NEXP * 768 + ((size_t)c0 * NEXP + e) * 192 + q * 12;
      *(unsigned*)(dst) = o[0]; *(unsigned*)(dst + 4) = o[1]; *(unsigned*)(dst + 8) = o[2];
      dst += (size_t)NEXP * 192;
      *(unsigned*)(dst) = o[3]; *(unsigned*)(dst + 4) = o[4]; *(unsigned*)(dst + 8) = o[5];
    }
  }
  for (int row = gw; row < 1024; row += NGW) {
    const int l = row >> 9, r = row & 511;
    const float4* xr = (const float4*)(p.mem + (size_t)r * DM) + lane;
    float4 v[4]; float ss = 0.f;
#pragma unroll
    for (int j = 0; j < 4; ++j) { v[j] = xr[64 * j]; ss += v[j].x * v[j].x + v[j].y * v[j].y + v[j].z * v[j].z + v[j].w * v[j].w; }
    ss = wave_sum(ss);
    const float rs = rsqrtf(ss * (1.f / DM) + EPS);
    const float4* gr = (const float4*)(p.g_mem + l * DM) + lane;
    uint2* o = (uint2*)((u16*)(ws + WS_MEMN) + (size_t)row * DM) + lane;
#pragma unroll
    for (int j = 0; j < 4; ++j) { float4 gg = gr[64 * j]; o[64 * j] = make_uint2(pk2(v[j].x * rs * gg.x, v[j].y * rs * gg.y), pk2(v[j].z * rs * gg.z, v[j].w * rs * gg.w)); }
  }
}

DEV void memkv_job(const Params& p, unsigned char* lds, int job) {
  unsigned char* ws = opaque_ptr(p.ws);
  const int l = job >> 5, kv = (job >> 4) & 1, rt = (job >> 2) & 3, nt = job & 3;
  const u16* A = (const u16*)(ws + WS_MEMN) + ((size_t)l * 512 + rt * 128) * DM;
  const u16* B = (const u16*)(ws + (kv ? WS_WT_XV : WS_WT_XK) + l * 2 * MiB) + (size_t)nt * 256 * DM;
  u16* memk = (u16*)(ws + WS_MEMK) + ((size_t)l * 512 + rt * 128) * DM;
  u16* memv = (u16*)(ws + WS_MEMVT) + ((size_t)l * 512 + rt * 128) * DM;
  gemm_run<16>(lds, 1,
    [=](int) { TileDesc d; d.A = A; d.lda = DM; d.B = B; d.ldb = 64; d.kb = 16384; return d; },
    [=](int, const f32x16 (&acc)[2][4], int wm, int wn, int lane) { epi_store_bf16(acc, wm, wn, lane, kv ? memv : memk, DM, nt * 256, 1.f); });
}

DEV void foldq_job(const Params& p, unsigned char* lds, int job) {
  unsigned char* ws = opaque_ptr(p.ws);
  const int l = job >> 5, b = (job >> 4) & 1, h = (job >> 2) & 3, mt = (job >> 1) & 1, kh = job & 1;
  const u16* A = (const u16*)(ws + WS_MEMK) + ((size_t)l * 512 + b * 256 + mt * 128) * DM + h * 256;
  const u16* wq = (const u16*)(ws + WS_WT_XQ + l * 2 * MiB) + h * 256;
  u16* mq = (u16*)(ws + WS_WT_MQ) + (size_t)(l * 2 + b) * 1024 * 1024;
  gemm_run<4>(lds, 2,
    [=](int j) { TileDesc d; d.A = A; d.lda = DM; d.B = wq + (size_t)(kh * 2 + j) * 256 * DM; d.ldb = DM; d.kb = 64; return d; },
    [=](int j, const f32x16 (&acc)[2][4], int wm, int wn, int lane) { epi_store_tiled(acc, wm, wn, lane, mq, h, mt * 128, (kh * 2 + j) * 256, 0.0625f); });
}

DEV void foldv_job(const Params& p, unsigned char* lds, int job) {
  unsigned char* ws = opaque_ptr(p.ws);
  const int l = job >> 5, b = (job >> 4) & 1, h = (job >> 2) & 3, mt = (job >> 1) & 1, nh = job & 1;
  const u16* A = (const u16*)(ws + WS_MEMVT) + ((size_t)l * 512 + b * 256 + mt * 128) * DM + h * 256;
  const u16* wt = (const u16*)(ws + WS_WT_XO + l * 2 * MiB) + (size_t)(4 * h) * 16384;
  u16* mo = (u16*)(ws + WS_WT_MO) + (size_t)(l * 2 + b) * 1024 * 1024;
  gemm_run<4>(lds, 2,
    [=](int j) { TileDesc d; d.A = A; d.lda = DM; d.B = wt + (size_t)(nh * 2 + j) * 256 * DM; d.ldb = 64; d.kb = 16384; return d; },
    [=](int j, const f32x16 (&acc)[2][4], int wm, int wn, int lane) { epi_store_tiledT(acc, wm, wn, lane, mo, nh * 2 + j, h * 256 + mt * 128); });
}

constexpr int P272 = 272;
DEV void stage_rows256(unsigned char* dst, const u16* src, int stride_elems) {
  const int tid = opaque_tid();
  const int row = tid >> 4, cc = tid & 15;
  const u16* p0 = src + (size_t)row * stride_elems + cc * 8;
  const uint4 a0 = *(const uint4*)(p0), a1 = *(const uint4*)(p0 + (size_t)32 * stride_elems), a2 = *(const uint4*)(p0 + (size_t)64 * stride_elems), a3 = *(const uint4*)(p0 + (size_t)96 * stride_elems);
  const int o = row * P272 + cc * 16;
  *(uint4*)(dst + o) = a0; *(uint4*)(dst + o + 32 * P272) = a1; *(uint4*)(dst + o + 64 * P272) = a2; *(uint4*)(dst + o + 96 * P272) = a3;
}
DEV void stage_rows256x3(unsigned char* d0, const u16* s0, int st0, unsigned char* d1, const u16* s1, int st1, unsigned char* d2, const u16* s2, int st2) {
  const int tid = opaque_tid();
  const int row = tid >> 4, cc = tid & 15;
  const u16* p0 = s0 + (size_t)row * st0 + cc * 8; const u16* p1 = s1 + (size_t)row * st1 + cc * 8; const u16* p2 = s2 + (size_t)row * st2 + cc * 8;
  const uint4 a0 = *(const uint4*)(p0), a1 = *(const uint4*)(p0 + (size_t)32 * st0), a2 = *(const uint4*)(p0 + (size_t)64 * st0), a3 = *(const uint4*)(p0 + (size_t)96 * st0);
  const uint4 b0 = *(const uint4*)(p1), b1 = *(const uint4*)(p1 + (size_t)32 * st1), b2 = *(const uint4*)(p1 + (size_t)64 * st1), b3 = *(const uint4*)(p1 + (size_t)96 * st1);
  const uint4 c0 = *(const uint4*)(p2), c1 = *(const uint4*)(p2 + (size_t)32 * st2), c2 = *(const uint4*)(p2 + (size_t)64 * st2), c3 = *(const uint4*)(p2 + (size_t)96 * st2);
  const int o = row * P272 + cc * 16;
  *(uint4*)(d0 + o) = a0; *(uint4*)(d0 + o + 32 * P272) = a1; *(uint4*)(d0 + o + 64 * P272) = a2; *(uint4*)(d0 + o + 96 * P272) = a3;
  *(uint4*)(d1 + o) = b0; *(uint4*)(d1 + o + 32 * P272) = b1; *(uint4*)(d1 + o + 64 * P272) = b2; *(uint4*)(d1 + o + 96 * P272) = b3;
  *(uint4*)(d2 + o) = c0; *(uint4*)(d2 + o + 32 * P272) = c1; *(uint4*)(d2 + o + 64 * P272) = c2; *(uint4*)(d2 + o + 96 * P272) = c3;
}

DEV void phaseA_tile(const Params& p, unsigned char* lds, int l_in, int tile_in) {
  int l = __builtin_amdgcn_readfirstlane(l_in), tile = __builtin_amdgcn_readfirstlane(tile_in);
  asm volatile("" : "+s"(l), "+s"(tile));
  unsigned char* ws = opaque_ptr(p.ws);
  const int tid = opaque_tid(), lane = tid & 63, wave = tid >> 6;
  const u16* hbuf = (const u16*)(ws + WS_KVLOC + (size_t)tile * 256 * 1024);
  u16* z = (u16*)(ws + WS_Z) + (size_t)tile * 128 * NIN;
  u16* kT = (u16*)(ws + WS_KT) + (size_t)tile * 4 * 16384;
  u16* vT = (u16*)(ws + WS_VT) + (size_t)tile * 4 * 16384;
  const u16* wt_in = (const u16*)(ws + WS_WT_IN + l * SZ_WT_IN1);
  float* gates = (float*)(ws + WS_GATES) + (size_t)tile * 128 * 8;

  gemm_run<16>(lds, 14,
    [=](int j) { TileDesc d; d.A = hbuf; d.lda = DM; d.B = wt_in + (size_t)j * 256 * DM; d.ldb = 64; d.kb = 16384; return d; },
    [=](int j, const f32x16 (&acc)[2][4], int wm, int wn, int ln) {
      if (j < 4) epi_store_u(acc, wm, wn, ln, z, NIN, j * 128);
      else if (j < 6) epi_store_bf16(acc, wm, wn, ln, z, NIN, 512 + (j - 4) * 256, 1.f);
      else if (j != 10 && j != 11) epi_store_bf16(acc, wm, wn, ln, z, NIN, j * 256, 1.f);
      if (j == 8 || j == 9) epi_store_bf16_T(acc, wm, wn, ln, kT, 128, (j - 8) * 256);
      if (j == 10 || j == 11) epi_store_bf16_T(acc, wm, wn, ln, vT, 128, (j - 10) * 256);
    });

  {
    const int w4 = wave & 3, kh = wave >> 2;
    f32x16 acc = zero16();
    const u16* arow = hbuf + (size_t)(w4 * 32 + (lane & 31)) * DM + kh * 512 + (lane >> 5) * 8;
    const u16* brow = wt_in + (size_t)(NIN + (lane & 31)) * DM + kh * 512 + (lane >> 5) * 8;
#pragma unroll 8
    for (int ks = 0; ks < 32; ++ks) acc = __builtin_amdgcn_mfma_f32_32x32x16_bf16(ld_frag_g(arow + ks * 16), ld_frag_g(brow + ks * 16), acc, 0, 0, 0);
    const int col = lane & 31;
    float* gx = (float*)lds + (w4 * 64 + (lane >> 5) * 8 + col) * 16;
    if (kh == 1 && col < 8) {
#pragma unroll
      for (int r = 0; r < 16; r += 4) *(float4*)(gx + r) = make_float4(acc[r], acc[r + 1], acc[r + 2], acc[r + 3]);
    }
    __syncthreads();
    if (kh == 0 && col < 8) {
      const float bias = p.b_if[l * 8 + col];
#pragma unroll
      for (int r = 0; r < 16; ++r) gates[(size_t)(w4 * 32 + rowmap(r, lane)) * 8 + col] = acc[r] + gx[r] + bias;
    }
  }
  {
    float* halo = (float*)(ws + WS_HALO) + ((size_t)(l * 256 + tile) * 2) * 512;
    __syncthreads();
    const int c = tid;
#pragma unroll
    for (int tt = 0; tt < 2; ++tt) {
      const size_t r = (size_t)(126 + tt) * NIN;
      halo[tt * 512 + c] = bf2f(z[r + c]);
    }
  }
  __syncthreads();
  float* kw = (float*)(lds + 2 * 34816);
  if (wave < 4) {
    const int h = wave;
    const int s0 = 2 * lane, s1 = s0 + 1;
    const float f0 = gates[s0 * 8 + 4 + h], f1 = gates[s1 * 8 + 4 + h];
    const float i0 = gates[s0 * 8 + h], i1 = gates[s1 * 8 + h];
    const float ls0 = fminf(f0, 0.f) - log1pf(__expf(-fabsf(f0))), ls1 = fminf(f1, 0.f) - log1pf(__expf(-fabsf(f1)));
    const float pr = ls0 + ls1;
    float inc = pr;
#pragma unroll
    for (int o = 1; o < 64; o <<= 1) { const float t = shfl_idx(inc, lane >= o ? lane - o : lane); if (lane >= o) inc += t; }
    const float b0 = (inc - pr) + ls0, b1 = b0 + ls1;
    const float bL = __builtin_bit_cast(float, __builtin_amdgcn_readlane(__builtin_bit_cast(int, inc), 63));
    const float g0 = bL - b0 + i0, g1 = bL - b1 + i1;
    const float ml = wave_max(fmaxf(g0, g1));
    const float sc = 0.08838834764831845f;
    kw[h * 128 + s0] = __expf(g0 - ml) * sc; kw[h * 128 + s1] = __expf(g1 - ml) * sc;
    float* bcum = (float*)(ws + WS_BCUM) + ((size_t)tile * 4 + h) * 128;
    bcum[s0] = b0; bcum[s1] = b1;
    if (lane == 0) { ((float*)(ws + WS_MLOC))[tile * 4 + h] = ml; ((float*)(ws + WS_BL))[tile * 4 + h] = bL; }
  }
  __syncthreads();
  float* kvloc = (float*)(ws + WS_KVLOC) + (size_t)tile * 4 * 16384;
  float* nloc = (float*)(ws + WS_NLOC) + (size_t)tile * 4 * 128;
  for (int h = 0; h < 4; ++h) {
    unsigned char* VTl = lds; unsigned char* KWl = lds + 34816;
    uint4 kreg[4];
#pragma unroll
    for (int i = 0; i < 4; ++i) { const int c = tid + i * NT, row = c >> 4, cc = c & 15; kreg[i] = *(const uint4*)(kT + h * 16384 + (size_t)row * 128 + cc * 8); }
    stage_rows256(VTl, vT + h * 16384, 128);
#pragma unroll
    for (int i = 0; i < 4; ++i) {
      const int c = tid + i * NT, row = c >> 4, cc = c & 15;
      const uint4 v = kreg[i];
      const float* kwp = kw + h * 128 + cc * 8;
      const float e0 = bflo(v.x) * kwp[0], e1 = bfhi(v.x) * kwp[1], e2 = bflo(v.y) * kwp[2], e3 = bfhi(v.y) * kwp[3];
      const float e4 = bflo(v.z) * kwp[4], e5 = bfhi(v.z) * kwp[5], e6 = bflo(v.w) * kwp[6], e7 = bfhi(v.w) * kwp[7];
      uint4 o; o.x = pk2(e0, e1); o.y = pk2(e2, e3); o.z = pk2(e4, e5); o.w = pk2(e6, e7);
      *(uint4*)(KWl + row * P272 + cc * 16) = o;
      float sm = ((e0 + e1) + (e2 + e3)) + ((e4 + e5) + (e6 + e7));
      sm += shx<1>(sm); sm += shx<2>(sm); sm += shx<4>(sm); sm += shx<8>(sm);
      if (cc == 0) nloc[h * 128 + row] = sm;
    }
    __syncthreads();
    {
      const int tr = wave >> 1, tc0 = (wave & 1) * 2;
      f32x16 a0 = zero16(), a1 = zero16();
      const unsigned char* ap = VTl + (tr * 32 + (lane & 31)) * P272 + (lane >> 5) * 16;
      const unsigned char* bp = KWl + (tc0 * 32 + (lane & 31)) * P272 + (lane >> 5) * 16;
#pragma unroll
      for (int ks = 0; ks < 8; ++ks) {
        const bf16x8 a = ld_frag(ap + ks * 32);
        a0 = __builtin_amdgcn_mfma_f32_32x32x16_bf16(a, ld_frag(bp + ks * 32), a0, 0, 0, 0);
        a1 = __builtin_amdgcn_mfma_f32_32x32x16_bf16(a, ld_frag(bp + 32 * P272 + ks * 32), a1, 0, 0, 0);
      }
      float* dst = kvloc + h * 16384;
#pragma unroll
      for (int r = 0; r < 16; ++r) {
        const int v = tr * 32 + rowmap(r, lane);
        dst[v * 128 + tc0 * 32 + (lane & 31)] = a0[r];
        dst[v * 128 + (tc0 + 1) * 32 + (lane & 31)] = a1[r];
      }
    }
    __syncthreads();
  }
}

DEV void phaseB(const Params& p, unsigned char* lds) {
  unsigned char* ws = opaque_ptr(p.ws);
  const int tid = opaque_tid();
  float* wd = (float*)lds; float* wl = wd + 128; float* mst = wl + 128; float* blv = mst + 128; float* mlv = blv + 128;
  for (int vb = blockIdx.x; vb < 256; vb += gridDim.x) {
    const int bh = vb >> 5, b = bh >> 2, h = bh & 3;
    const int e = (vb & 31) * 512 + tid;
    __syncthreads();
    if (tid < 128) { const int tile = b * 128 + tid; blv[tid] = ((const float*)(ws + WS_BL))[tile * 4 + h]; mlv[tid] = ((const float*)(ws + WS_MLOC))[tile * 4 + h]; }
    __syncthreads();
    if (tid == 0) {
      float m = 0.f;
      for (int c = 0; c < 128; ++c) {
        const float bl = blv[c], ml = mlv[c];
        const float mn = fmaxf(bl + m, ml);
        wd[c] = __expf(bl + m - mn); wl[c] = __expf(ml - mn); mst[c] = m; m = mn;
      }
    }
    __syncthreads();
    const float* kv = (const float*)(ws + WS_KVLOC) + ((size_t)(b * 128) * 4 + h) * 16384 + e;
    u16* cs = (u16*)(ws + WS_CSTATE) + ((size_t)(b * 128) * 4 + h) * 16384 + e;
    float C = 0.f;
#pragma unroll 1
    for (int c0 = 0; c0 < 128; c0 += 32) {
      float v[32];
#pragma unroll
      for (int q = 0; q < 32; ++q) v[q] = kv[(size_t)(c0 + q) * 4 * 16384];
#pragma unroll
      for (int q = 0; q < 32; ++q) {
        cs[(size_t)(c0 + q) * 4 * 16384] = f2bf(C);
        C = wd[c0 + q] * C + wl[c0 + q] * v[q];
      }
    }
    if ((vb & 31) == 0 && tid < 128) {
      const float* nl = (const float*)(ws + WS_NLOC) + ((size_t)(b * 128) * 4 + h) * 128 + tid;
      float* ns = (float*)(ws + WS_NSTATE) + ((size_t)(b * 128) * 4 + h) * 128 + tid;
      float n = 0.f;
      for (int c = 0; c < 128; ++c) { ns[(size_t)c * 512] = n; n = wd[c] * n + wl[c] * nl[(size_t)c * 512]; }
      ((float*)(ws + WS_MSTATE))[(b * 128 + tid) * 4 + h] = mst[tid];
    }
  }
}

DEV float erf_as(float x) {
  const float ax = fabsf(x);
  const float t = __builtin_amdgcn_rcpf(1.f + 0.3275911f * ax);
  const float poly = ((((1.061405429f * t - 1.453152027f) * t + 1.421413741f) * t - 0.284496736f) * t + 0.254829592f) * t;
  const float y = 1.f - poly * __expf(-ax * ax);
  return copysignf(y, x);
}
DEV unsigned ordkey(float f) { const unsigned u = __float_as_uint(f); return (u & 0x80000000u) ? ~u : (u | 0x80000000u); }
DEV float unordkey(unsigned k) { return (k & 0x80000000u) ? __uint_as_float(k & 0x7fffffffu) : __uint_as_float(~k); }
#define CE_DESC(a, b) { const unsigned hi__ = max(a, b), lo__ = min(a, b); a = hi__; b = lo__; }
DEV void sort16_desc(unsigned (&a)[16]) {
#pragma unroll
  for (int k = 2; k <= 16; k <<= 1) {
#pragma unroll
    for (int j = k >> 1; j > 0; j >>= 1) {
#pragma unroll
      for (int i = 0; i < 16; ++i) {
        const int l = i ^ j;
        if (l > i) {
          if ((i & k) == 0 || k == 16) { CE_DESC(a[i], a[l]); } else { CE_DESC(a[l], a[i]); }
        }
      }
    }
  }
}
DEV void merge16_desc(unsigned (&a)[16]) {
#pragma unroll
  for (int j = 8; j > 0; j >>= 1) {
#pragma unroll
    for (int i = 0; i < 16; ++i) { const int l = i ^ j; if (l > i) { CE_DESC(a[i], a[l]); } }
  }
}
#define INSERT16(list, key_)                                                         \
  {                                                                                  \
    unsigned kx_ = (key_);                                                           \
    _Pragma("unroll") for (int q_ = 0; q_ < 16; ++q_) {                              \
      const unsigned hi_ = max(list[q_], kx_); kx_ = min(list[q_], kx_); list[q_] = hi_; \
    }                                                                                \
  }

DEV void epi_topk1(const f32x16 (&acc)[2][4], int wm, int wn, int lane, int hh, const float* rsv, unsigned* topG) {
  const int tl = lane & 31, h = lane >> 5;
#pragma unroll
  for (int mi = 0; mi < 2; ++mi) {
    const int row = wm * 64 + mi * 32 + tl;
    const float rs = rsv[row];
    unsigned L[16];
#pragma unroll
    for (int ni = 0; ni < 4; ++ni) {
      unsigned B[16];
#pragma unroll
      for (int r = 0; r < 16; ++r) B[r] = (ordkey(acc[mi][ni][r] * rs) & ~127u) | (unsigned)(127 - (ni * 32 + 8 * (r >> 2) + 4 * h + (r & 3)));
      sort16_desc(B);
      if (ni == 0) {
#pragma unroll
        for (int i = 0; i < 16; ++i) L[i] = B[i];
      } else {
#pragma unroll
        for (int i = 0; i < 16; ++i) L[i] = max(L[i], B[15 - i]);
        merge16_desc(L);
      }
    }
    unsigned P[16];
#pragma unroll
    for (int i = 0; i < 16; ++i) P[i] = (unsigned)__builtin_amdgcn_ds_bpermute((lane ^ 32) << 2, (int)L[i]);
#pragma unroll
    for (int i = 0; i < 16; ++i) L[i] = max(L[i], P[15 - i]);
    merge16_desc(L);
    if (h == 0) {
      uint4* tp = (uint4*)(topG + ((size_t)(hh * 2 + wn) * 128 + row) * 16);
      tp[0] = make_uint4(L[0], L[1], L[2], L[3]); tp[1] = make_uint4(L[4], L[5], L[6], L[7]);
      tp[2] = make_uint4(L[8], L[9], L[10], L[11]); tp[3] = make_uint4(L[12], L[13], L[14], L[15]);
    }
  }
}
DEV void topk_stage2(const unsigned* topG, int t, int hh, unsigned char* R4) {
  unsigned L0[16], L1[16];
  {
    const uint4* p0 = (const uint4*)(topG + ((size_t)(hh * 2 + 0) * 128 + t) * 16); const uint4* p1 = (const uint4*)(topG + ((size_t)(hh * 2 + 1) * 128 + t) * 16);
#pragma unroll
    for (int q = 0; q < 4; ++q) {
      const uint4 a = p0[q], b = p1[q];
      L0[4 * q] = a.x; L0[4 * q + 1] = a.y; L0[4 * q + 2] = a.z; L0[4 * q + 3] = a.w;
      L1[4 * q] = b.x; L1[4 * q + 1] = b.y; L1[4 * q + 2] = b.z; L1[4 * q + 3] = b.w;
    }
  }
  float v0[16], v1[16];
#pragma unroll
  for (int i = 0; i < 16; ++i) { v0[i] = unordkey(L0[i] & ~127u); v1[i] = unordkey(L1[i] & ~127u); }
#define PK_KEY(i_, j_) ((ordkey(v0[i_] + v1[j_]) & ~255u) | (unsigned)(255 - ((i_) * 16 + (j_))))
  unsigned L2[16], A1[16], B0[16], B1[16];
#pragma unroll
  for (int j = 0; j < 16; ++j) L2[j] = PK_KEY(0, j);
#pragma unroll
  for (int j = 0; j < 8; ++j) { A1[j] = PK_KEY(1, j); A1[8 + j] = 0u; }
#pragma unroll
  for (int i = 0; i < 16; ++i) L2[i] = max(L2[i], A1[15 - i]);
  merge16_desc(L2);
  B0[0] = PK_KEY(2, 0); B0[1] = PK_KEY(2, 1); B0[2] = PK_KEY(2, 2); B0[3] = PK_KEY(2, 3); B0[4] = PK_KEY(2, 4);
  B0[5] = PK_KEY(3, 0); B0[6] = PK_KEY(3, 1); B0[7] = PK_KEY(3, 2); B0[8] = PK_KEY(3, 3);
  B0[9] = PK_KEY(4, 0); B0[10] = PK_KEY(4, 1); B0[11] = PK_KEY(4, 2);
  B0[12] = PK_KEY(5, 0); B0[13] = PK_KEY(5, 1); B0[14] = PK_KEY(6, 0); B0[15] = PK_KEY(6, 1);
  B1[0] = PK_KEY(7, 0); B1[1] = PK_KEY(7, 1);
#pragma unroll
  for (int i = 8; i < 16; ++i) B1[i - 6] = PK_KEY(i, 0);
#pragma unroll
  for (int i = 10; i < 16; ++i) B1[i] = 0u;
  sort16_desc(B0); sort16_desc(B1);
#pragma unroll
  for (int i = 0; i < 16; ++i) B0[i] = max(B0[i], B1[15 - i]);
  merge16_desc(B0);
#pragma unroll
  for (int i = 0; i < 16; ++i) L2[i] = max(L2[i], B0[15 - i]);
  merge16_desc(L2);
#undef PK_KEY
  float fv[16]; int eid[16];
  unsigned p0[4], p1[4];
#pragma unroll
  for (int w = 0; w < 4; ++w) {
    p0[w] = (127u - (L0[4 * w] & 127u)) | ((127u - (L0[4 * w + 1] & 127u)) << 8) | ((127u - (L0[4 * w + 2] & 127u)) << 16) | ((127u - (L0[4 * w + 3] & 127u)) << 24);
    p1[w] = (127u - (L1[4 * w] & 127u)) | ((127u - (L1[4 * w + 1] & 127u)) << 8) | ((127u - (L1[4 * w + 2] & 127u)) << 16) | ((127u - (L1[4 * w + 3] & 127u)) << 24);
  }
#pragma unroll
  for (int k = 0; k < 16; ++k) {
    fv[k] = unordkey(L2[k] & ~255u);
    const unsigned c = 255u - (L2[k] & 255u), ci = c >> 4, cj = c & 15u;
    const unsigned a_lo = (ci & 8u) ? p0[2] : p0[0], a_hi = (ci & 8u) ? p0[3] : p0[1];
    const unsigned b_lo = (cj & 8u) ? p1[2] : p1[0], b_hi = (cj & 8u) ? p1[3] : p1[1];
    const unsigned i0 = __builtin_amdgcn_perm(a_hi, a_lo, 0x0c0c0c00u | (ci & 7u));
    const unsigned i1 = __builtin_amdgcn_perm(b_hi, b_lo, 0x0c0c0c00u | (cj & 7u));
    eid[k] = (int)(i0 * 128u + i1);
  }
  float sum = 0.f;
  const float fmx = fv[0];
#pragma unroll
  for (int k = 0; k < 16; ++k) { fv[k] = __expf(fv[k] - fmx); sum += fv[k]; }
  const float inv = 1.f / sum;
  int* eo = (int*)(R4 + (size_t)t * 1024) + hh * 16;
  float* go = (float*)(R4 + (size_t)t * 1024 + 512) + hh * 16;
#pragma unroll
  for (int k = 0; k < 16; k += 4) {
    *(int4*)(eo + k) = make_int4(eid[k], eid[k + 1], eid[k + 2], eid[k + 3]);
    *(float4*)(go + k) = make_float4(fv[k] * inv, fv[k + 1] * inv, fv[k + 2] * inv, fv[k + 3] * inv);
  }
}

DEV void phaseC_tile(const Params& p, unsigned char* lds, int l_in, int tile_in, bool last) {
  int l = __builtin_amdgcn_readfirstlane(l_in), tile = __builtin_amdgcn_readfirstlane(tile_in);
  asm volatile("" : "+s"(l), "+s"(tile));
  unsigned char* ws = opaque_ptr(p.ws);
  const int tid = opaque_tid(), lane = tid & 63, wave = tid >> 6;
  const int bidx = tile >> 7;
  u16* z = (u16*)(ws + WS_Z) + (size_t)tile * 128 * NIN;
  unsigned char* zslot = ws + WS_Z + (size_t)tile * ZSLOT;
  u16* R1 = (u16*)(ws + WS_KVLOC + (size_t)tile * 256 * 1024);
  u16* R2 = (u16*)(zslot + R2_OFF);
  unsigned char* R3 = zslot + R3_OFF;
  unsigned char* R4 = zslot + R4_OFF;
  u16* xs = (u16*)(p.out + (size_t)tile * 128 * DM + 65536);
  const void* xsrc = (l == 0) ? (const void*)(p.x + (size_t)tile * 128 * DM) : (const void*)xs;
  const float* gates = (const float*)(ws + WS_GATES) + (size_t)tile * 128 * 8;

  {
    unsigned char* KPl = lds; unsigned char* VTl = lds + 34816; unsigned char* CTl = lds + 69632;
    float* sm = (float*)(lds + 104448);
    float* avs = sm; float* Mt = sm + 128; float* iwv = sm + 256; float* emt = sm + 384; float* nrm = sm + 512; float* nst = sm + 640;
    float* HL = (float*)VTl;
    const int rb = wave >> 1, half = wave & 1;
    for (int h = 0; h < 4; ++h) {
      stage_rows256x3(KPl, z + 2048 + h * 128, NIN, VTl, (const u16*)(ws + WS_VT) + ((size_t)tile * 4 + h) * 16384, 128, CTl, (const u16*)(ws + WS_CSTATE) + ((size_t)tile * 4 + h) * 16384, 128);
      const float mprev = ((const float*)(ws + WS_MSTATE))[tile * 4 + h];
      if (wave == 0) {
        const int s0 = 2 * lane, s1 = s0 + 1;
        const float* bc = (const float*)(ws + WS_BCUM) + ((size_t)tile * 4 + h) * 128;
        const float b0 = bc[s0], b1 = bc[s1];
        const float a0 = gates[s0 * 8 + h] - b0, a1 = gates[s1 * 8 + h] - b1;
        float v = fmaxf(a0, a1);
#pragma unroll
        for (int o = 1; o < 64; o <<= 1) { const float t = shfl_idx(v, lane >= o ? lane - o : lane); if (lane >= o) v = fmaxf(v, t); }
        float ex = shfl_idx(v, lane >= 1 ? lane - 1 : lane); if (lane == 0) ex = -INFINITY;
        const float A0 = fmaxf(ex, a0), A1 = fmaxf(A0, a1);
        const float M0 = fmaxf(mprev, A0), M1 = fmaxf(mprev, A1);
        avs[s0] = a0; avs[s1] = a1; Mt[s0] = M0; Mt[s1] = M1;
        iwv[s0] = __expf(mprev - M0); iwv[s1] = __expf(mprev - M1);
        emt[s0] = __expf(-b0 - M0); emt[s1] = __expf(-b1 - M1);
      } else if (wave == 1) {
        const float* ns = (const float*)(ws + WS_NSTATE) + ((size_t)tile * 4 + h) * 128;
        nst[lane] = ns[lane]; nst[lane + 64] = ns[lane + 64];
      }
      bf16x8 qf[8];
      {
        const u16* qrow = z + (size_t)(rb * 32 + (lane & 31)) * NIN + 1536 + h * 128 + (lane >> 5) * 8;
#pragma unroll
        for (int ks = 0; ks < 8; ++ks) qf[ks] = ld_frag_g(qrow + ks * 16);
      }
      __syncthreads();
      f32x16 s0a = zero16(), s1a = zero16();
      {
        const unsigned char* bp = KPl + (half * 64 + (lane & 31)) * P272 + (lane >> 5) * 16;
#pragma unroll
        for (int ks = 0; ks < 8; ++ks) {
          s0a = __builtin_amdgcn_mfma_f32_32x32x16_bf16(qf[ks], ld_frag(bp + ks * 32), s0a, 0, 0, 0);
          s1a = __builtin_amdgcn_mfma_f32_32x32x16_bf16(qf[ks], ld_frag(bp + 32 * P272 + ks * 32), s1a, 0, 0, 0);
        }
      }
      {
        const float sc = 0.08838834764831845f;
        const int sA = half * 64 + (lane & 31), sB = sA + 32;
        const float avA = avs[sA], avB = avs[sB];
#pragma unroll
        for (int g = 0; g < 4; ++g) {
          const int t0 = rb * 32 + 8 * g + 4 * (lane >> 5);
          const float4 m4 = *(const float4*)(Mt + t0);
          const float mm[4] = {m4.x, m4.y, m4.z, m4.w};
#pragma unroll
          for (int e = 0; e < 4; ++e) {
            const int t = t0 + e;
            s0a[4 * g + e] = (sA <= t) ? s0a[4 * g + e] * sc * __expf(avA - mm[e]) : 0.f;
            s1a[4 * g + e] = (sB <= t) ? s1a[4 * g + e] * sc * __expf(avB - mm[e]) : 0.f;
          }
        }
      }
      __syncthreads();
      {
        u16* P = (u16*)KPl;
        const int sA = half * 64 + (lane & 31), sB = sA + 32;
#pragma unroll
        for (int r = 0; r < 16; ++r) {
          const int t = rb * 32 + rowmap(r, lane);
          P[t * (P272 / 2) + sA] = f2bf(s0a[r]);
          P[t * (P272 / 2) + sB] = f2bf(s1a[r]);
        }
      }
      __syncthreads();
      {
        const int t = tid >> 2, qd = tid & 3;
        const unsigned char* pr = KPl + t * P272 + qd * 64;
        float rs = 0.f;
#pragma unroll
        for (int i = 0; i < 4; ++i) { const uint4 v = *(const uint4*)(pr + i * 16); rs += (bflo(v.x) + bfhi(v.x)) + (bflo(v.y) + bfhi(v.y)) + (bflo(v.z) + bfhi(v.z)) + (bflo(v.w) + bfhi(v.w)); }
        const u16* qr = z + (size_t)t * NIN + 1536 + h * 128 + qd * 32;
        const float* nn = nst + qd * 32;
        float qn = 0.f;
#pragma unroll
        for (int i = 0; i < 4; ++i) {
          const uint4 v = *(const uint4*)(qr + i * 8);
          qn += bflo(v.x) * nn[i * 8 + 0] + bfhi(v.x) * nn[i * 8 + 1] + bflo(v.y) * nn[i * 8 + 2] + bfhi(v.y) * nn[i * 8 + 3] +
                bflo(v.z) * nn[i * 8 + 4] + bfhi(v.z) * nn[i * 8 + 5] + bflo(v.w) * nn[i * 8 + 6] + bfhi(v.w) * nn[i * 8 + 7];
        }
        rs += shx<1>(rs); rs += shx<2>(rs);
        qn += shx<1>(qn); qn += shx<2>(qn);
        const float den = rs + iwv[t] * qn;
        if (qd == 0) nrm[t] = 1.f / fmaxf(fabsf(den), emt[t]);
      }
      f32x16 n0 = zero16(), n1 = zero16(), c0 = zero16(), c1 = zero16();
      {
        const unsigned char* ap = KPl + (rb * 32 + (lane & 31)) * P272 + (lane >> 5) * 16;
        const unsigned char* vp = VTl + (half * 64 + (lane & 31)) * P272 + (lane >> 5) * 16;
        const unsigned char* cp = CTl + (half * 64 + (lane & 31)) * P272 + (lane >> 5) * 16;
#pragma unroll
        for (int ks = 0; ks < 8; ++ks) {
          const bf16x8 a = ld_frag(ap + ks * 32);
          n0 = __builtin_amdgcn_mfma_f32_32x32x16_bf16(a, ld_frag(vp + ks * 32), n0, 0, 0, 0);
          n1 = __builtin_amdgcn_mfma_f32_32x32x16_bf16(a, ld_frag(vp + 32 * P272 + ks * 32), n1, 0, 0, 0);
          c0 = __builtin_amdgcn_mfma_f32_32x32x16_bf16(qf[ks], ld_frag(cp + ks * 32), c0, 0, 0, 0);
          c1 = __builtin_amdgcn_mfma_f32_32x32x16_bf16(qf[ks], ld_frag(cp + 32 * P272 + ks * 32), c1, 0, 0, 0);
        }
      }
      __syncthreads();
      {
        const int vA = half * 64 + (lane & 31), vB = vA + 32;
#pragma unroll
        for (int g = 0; g < 4; ++g) {
          const int t0 = rb * 32 + 8 * g + 4 * (lane >> 5);
          const float4 iw4 = *(const float4*)(iwv + t0), nr4 = *(const float4*)(nrm + t0);
          const float iw[4] = {iw4.x, iw4.y, iw4.z, iw4.w}, nr[4] = {nr4.x, nr4.y, nr4.z, nr4.w};
#pragma unroll
          for (int e = 0; e < 4; ++e) {
            const int t = t0 + e;
            const float hA = (n0[4 * g + e] + iw[e] * c0[4 * g + e]) * nr[e];
            const float hB = (n1[4 * g + e] + iw[e] * c1[4 * g + e]) * nr[e];
            const float oA = bf2f(z[(size_t)t * NIN + 3072 + h * 128 + vA]), oB = bf2f(z[(size_t)t * NIN + 3072 + h * 128 + vB]);
            HL[t * 132 + vA] = hA / (1.f + __expf(-oA));
            HL[t * 132 + vB] = hB / (1.f + __expf(-oB));
          }
        }
      }
      __syncthreads();
      {
        const int t = tid >> 2, qd = tid & 3;
        const float* hr = HL + t * 132 + qd * 32;
        float v[32]; float ss = 0.f;
#pragma unroll
        for (int i = 0; i < 8; ++i) { const float4 f = *(const float4*)(hr + i * 4); v[4 * i] = f.x; v[4 * i + 1] = f.y; v[4 * i + 2] = f.z; v[4 * i + 3] = f.w; ss += f.x * f.x + f.y * f.y + f.z * f.z + f.w * f.w; }
        ss += shx<1>(ss); ss += shx<2>(ss);
        const float r = rsqrtf(ss * (1.f / 128.f) + EPS);
        const float* gh = p.g_head + l * 512 + h * 128 + qd * 32;
        u16* yo = R1 + (size_t)t * DM + 512 + h * 128 + qd * 32;
#pragma unroll
        for (int i = 0; i < 4; ++i) {
          uint4 o;
          o.x = pk2(v[8 * i + 0] * r * gh[8 * i + 0], v[8 * i + 1] * r * gh[8 * i + 1]);
          o.y = pk2(v[8 * i + 2] * r * gh[8 * i + 2], v[8 * i + 3] * r * gh[8 * i + 3]);
          o.z = pk2(v[8 * i + 4] * r * gh[8 * i + 4], v[8 * i + 5] * r * gh[8 * i + 5]);
          o.w = pk2(v[8 * i + 6] * r * gh[8 * i + 6], v[8 * i + 7] * r * gh[8 * i + 7]);
          *(uint4*)(yo + i * 8) = o;
        }
      }
      __syncthreads();
    }
  }
  {
    const int c = (tid & 255) * 2, th = tid >> 8, t0 = th * 64;
    const float2 w0 = *(const float2*)(p.conv_w + (l * 3 + 0) * 512 + c), w1 = *(const float2*)(p.conv_w + (l * 3 + 1) * 512 + c), w2 = *(const float2*)(p.conv_w + (l * 3 + 2) * 512 + c);
    const float2 cb = *(const float2*)(p.conv_b + l * 512 + c);
    float2 um2 = make_float2(0.f, 0.f), um1 = make_float2(0.f, 0.f);
    if (th == 1) {
      const unsigned xa = *(const unsigned*)(z + (size_t)62 * NIN + c), xb = *(const unsigned*)(z + (size_t)63 * NIN + c);
      um2 = make_float2(bflo(xa), bfhi(xa)); um1 = make_float2(bflo(xb), bfhi(xb));
    } else if ((tile & 127) != 0) {
      const float* halo = (const float*)(ws + WS_HALO) + ((size_t)(l * 256 + tile - 1) * 2) * 512;
      um2 = *(const float2*)(halo + c); um1 = *(const float2*)(halo + 512 + c);
    }
#pragma unroll 1
    for (int tb = t0; tb < t0 + 64; tb += 8) {
      unsigned xw[8], bw[8];
#pragma unroll
      for (int q = 0; q < 8; ++q) { const size_t r = (size_t)(tb + q) * NIN; xw[q] = *(const unsigned*)(z + r + c); bw[q] = *(const unsigned*)(z + r + 512 + c); }
#pragma unroll
      for (int q = 0; q < 8; ++q) {
        const float2 u = make_float2(bflo(xw[q]), bfhi(xw[q]));
        const float y0 = bflo(bw[q]) * (w0.x * um2.x + w1.x * um1.x + w2.x * u.x + cb.x);
        const float y1 = bfhi(bw[q]) * (w0.y * um2.y + w1.y * um1.y + w2.y * u.y + cb.y);
        *(unsigned*)(R1 + (size_t)(tb + q) * DM + c) = pk2(y0, y1);
        um2 = um1; um1 = u;
      }
    }
  }
  __syncthreads();
  float* rowss = (float*)(lds + 110592 + 1024); float* rsv = (float*)(lds + 110592);
  {
    const u16* wt = (const u16*)(ws + WS_WT_OUT + l * 2 * MiB);
    const float* gx = p.g_xattn + l * DM;
    u16* xg = (u16*)R3;
    gemm_run<16>(lds, 4,
      [=](int j) { TileDesc d; d.A = R1; d.lda = DM; d.B = wt + (size_t)j * 256 * DM; d.ldb = 64; d.kb = 16384; return d; },
      [=](int j, const f32x16 (&acc)[2][4], int wm, int wn, int ln) { epi_residual_norm(acc, wm, wn, ln, xsrc, l == 0, xs, j * 256, gx, (u16*)nullptr, rowss); });
    if (tid < 128) { float s_ = 0.f;
#pragma unroll
      for (int q = 0; q < 8; ++q) s_ += rowss[q * 128 + tid];
      rsv[tid] = rsqrtf(s_ * (1.f / DM) + EPS); }
  }
  {
    const u16* wt = (const u16*)(ws + WS_WT_MQ) + (size_t)(l * 2 + bidx) * 1024 * 1024;
    const u16* xg = xs;
    float* pm = (float*)(lds + 110592 + 1024); float* ps = pm + 256;
    gemm_run<16, 3>(lds, 4,
      [=](int j) { TileDesc d; d.A = xg; d.lda = DM; d.B = wt + (size_t)j * 256 * DM; d.ldb = 64; d.kb = 16384; return d; },
      [=](int j, const f32x16 (&acc)[2][4], int wm, int wn, int ln) { epi_softmax_bf16(acc, wm, wn, ln, R2, DM, j * 256, rsv, pm, ps); });
  }
  {
    const u16* wt = (const u16*)(ws + WS_WT_MO) + (size_t)(l * 2 + bidx) * 1024 * 1024;
    const u16* ao = (const u16*)R2;
    const float* gf = p.g_ffn + l * DM;
    gemm_run<16>(lds, 4,
      [=](int j) { TileDesc d; d.A = ao; d.lda = DM; d.B = wt + (size_t)j * 256 * DM; d.ldb = 64; d.kb = 16384; return d; },
      [=](int j, const f32x16 (&acc)[2][4], int wm, int wn, int ln) { epi_residual_norm(acc, wm, wn, ln, xs, false, xs, j * 256, gf, R1, rowss); });
    if (tid < 128) { float s_ = 0.f;
#pragma unroll
      for (int q = 0; q < 8; ++q) s_ += rowss[q * 128 + tid];
      rsv[tid] = rsqrtf(s_ * (1.f / DM) + EPS); }
  }
  {
    const u16* wt = (const u16*)(ws + WS_WT_PQ + l * 4 * MiB);
    unsigned* topG = (unsigned*)R3;
    gemm_run<16, 0, true>(lds, 8,
      [=](int j) { TileDesc d; d.A = R1; d.lda = DM; d.B = wt + (size_t)j * 256 * DM; d.ldb = 64; d.kb = 16384; return d; },
      [=](int j, const f32x16 (&acc)[2][4], int wm, int wn, int ln) { epi_topk1(acc, wm, wn, ln, j, rsv, topG); });
#pragma unroll 1
    for (int it = 0; it < 2; ++it) topk_stage2(topG, tid & 127, (tid >> 7) + 4 * it, R4);
    __syncthreads();
  }
}

DEV void grid_barrier(cg::grid_group& grid) {
  asm volatile("s_waitcnt vmcnt(0)" ::: "memory");
  __syncthreads();
  grid.sync();
  __builtin_amdgcn_fence(__ATOMIC_ACQUIRE, "agent");
  asm volatile("s_waitcnt vmcnt(0)" ::: "memory");
  __syncthreads();
}
DEV void grid_barrier_ctr(unsigned* ctr, unsigned target) {
  asm volatile("s_waitcnt vmcnt(0)" ::: "memory");
  __syncthreads();
  if (threadIdx.x == 0) {
    __builtin_amdgcn_fence(__ATOMIC_RELEASE, "agent");
    asm volatile("s_waitcnt vmcnt(0)" ::: "memory");
    __hip_atomic_fetch_add(ctr, 1u, __ATOMIC_RELAXED, __HIP_MEMORY_SCOPE_AGENT);
    while (__hip_atomic_load(ctr, __ATOMIC_RELAXED, __HIP_MEMORY_SCOPE_AGENT) < target) __builtin_amdgcn_s_sleep(2);
  }
  __syncthreads();
  __builtin_amdgcn_fence(__ATOMIC_ACQUIRE, "agent");
  asm volatile("s_waitcnt vmcnt(0)" ::: "memory");
  __syncthreads();
}

DEV void peer_gather(const Params& p, unsigned char* lds, int l_in, int tile_in, bool last, bool active, unsigned* bar, unsigned& nbar) {
  int l = __builtin_amdgcn_readfirstlane(l_in), tile = __builtin_amdgcn_readfirstlane(tile_in);
  asm volatile("" : "+s"(l), "+s"(tile));
  unsigned char* ws = opaque_ptr(p.ws);
  const int tid = opaque_tid(), lane = tid & 63, wave = __builtin_amdgcn_readfirstlane(tid >> 6);
  const int q = lane & 15, g4 = lane >> 4, q12 = q * 12;
  u16* R1 = (u16*)(ws + WS_KVLOC + (size_t)tile * 256 * 1024);
  unsigned char* R4 = ws + WS_Z + (size_t)tile * ZSLOT + R4_OFF;
  float* xout = p.out + (size_t)tile * 128 * DM;
  u16* xs = (u16*)(xout + 65536);
  int* eidL = (int*)lds;
  float* hacc = (float*)(lds + 65536);
  float* rsvG = (float*)(lds + 131072);
  float* ssq = rsvG + 128;
  const unsigned char* utab = ws + WS_EXP6 + (size_t)(l * 2 + 0) * NEXP * 768;
  const unsigned char* vtab = ws + WS_EXP6 + (size_t)(l * 2 + 1) * NEXP * 768;

  if (active) {
    const float* rsv = (const float*)(lds + 110592);
    float rv = 0.f;
    if (tid < 128) rv = rsv[tid];
    __syncthreads();
    if (tid < 128) rsvG[tid] = rv;
    {
      int ev[32];
#pragma unroll
      for (int i = 0; i < 16; ++i) {
        const int* eo = (const int*)(R4 + (size_t)(wave + 8 * i) * 1024);
        ev[2 * i] = eo[lane]; ev[2 * i + 1] = eo[lane + 64];
      }
#pragma unroll
      for (int i = 0; i < 16; ++i) {
        const int t = wave + 8 * i;
#pragma unroll
        for (int r = 0; r < 2; ++r) {
          const int sel = lane + 64 * r;
          eidL[t * 128 + (sel & 3) * 32 + 2 * (sel >> 3) + ((sel >> 2) & 1)] = ev[2 * i + r];
        }
      }
    }
    __syncthreads();
  }

#define SEG_LD(rsrc_, e_) __builtin_amdgcn_raw_buffer_load_b96(rsrc_, (int)(__umul24((unsigned)(e_), 192u) + (unsigned)q12), 0, 0)
#define LD_GROUP(S_, rsrc_, t_, G_) { const int4* ep_ = (const int4*)(eidL + (t_) * 128 + g4 * 32 + 16 * (G_)); \
    const int4 e0_ = ep_[0], e1_ = ep_[1], e2_ = ep_[2], e3_ = ep_[3]; \
    S_[0] = SEG_LD(rsrc_, e0_.x); S_[1] = SEG_LD(rsrc_, e0_.y); S_[2] = SEG_LD(rsrc_, e0_.z); S_[3] = SEG_LD(rsrc_, e0_.w); \
    S_[4] = SEG_LD(rsrc_, e1_.x); S_[5] = SEG_LD(rsrc_, e1_.y); S_[6] = SEG_LD(rsrc_, e1_.z); S_[7] = SEG_LD(rsrc_, e1_.w); \
    S_[8] = SEG_LD(rsrc_, e2_.x); S_[9] = SEG_LD(rsrc_, e2_.y); S_[10] = SEG_LD(rsrc_, e2_.z); S_[11] = SEG_LD(rsrc_, e2_.w); \
    S_[12] = SEG_LD(rsrc_, e3_.x); S_[13] = SEG_LD(rsrc_, e3_.y); S_[14] = SEG_LD(rsrc_, e3_.z); S_[15] = SEG_LD(rsrc_, e3_.w); }

#pragma unroll 1
  for (int c = 0; c < 4; ++c) {
    if (active) {
      const __amdgpu_buffer_rsrc_t rsrc = mkrsrc(utab + (size_t)c * NEXP * 192);
      u32x3 s0[16], s1[16];
      u32x2 hx[4];
      {
        const GAS u32x2* xrow = (const GAS u32x2*)(R1 + (size_t)wave * DM) + 64 * c + q;
#pragma unroll
        for (int j = 0; j < 4; ++j) hx[j] = xrow[16 * j];
        LD_GROUP(s0, rsrc, wave, 0);
      }
#pragma unroll 1
      for (int i = 0; i < 16; ++i) {
        const int t = wave + 8 * i, tn = wave + 8 * (i < 15 ? i + 1 : 15);
        float P[32];
        LD_GROUP(s1, rsrc, t, 1);
        u32x2 hxn[4];
        {
          const GAS u32x2* xrow = (const GAS u32x2*)(R1 + (size_t)tn * DM) + 64 * c + q;
#pragma unroll
          for (int j = 0; j < 4; ++j) hxn[j] = xrow[16 * j];
        }
        const unsigned hvb[8] = {hx[0].x, hx[0].y, hx[1].x, hx[1].y, hx[2].x, hx[2].y, hx[3].x, hx[3].y};
#define U_PAIR(S_, pp_, base_) { \
          u32x6 w_ = (u32x6){S_[2 * (pp_)].x, S_[2 * (pp_)].y, S_[2 * (pp_)].z, S_[2 * (pp_) + 1].x, S_[2 * (pp_) + 1].y, S_[2 * (pp_) + 1].z}; \
          asm volatile("" : "+v"(w_));        \
          const bf16x32 uf = __builtin_amdgcn_cvt_scalef32_pk32_bf16_fp6(w_, 1.0f); \
          float sa = 0.f, sb = 0.f; \
          U_DOT(0) U_DOT(1) U_DOT(2) U_DOT(3) U_DOT(4) U_DOT(5) U_DOT(6) U_DOT(7) \
          P[(base_) + 2 * (pp_)] = sa; P[(base_) + 2 * (pp_) + 1] = sb; \
          __builtin_amdgcn_sched_barrier(0); }
#define U_DOT(I) sa = __builtin_amdgcn_fdot2_f32_bf16(__builtin_shufflevector(uf, uf, 2 * (I), 2 * (I) + 1), __builtin_bit_cast(bf16x2, hvb[I]), sa, false); \
                 sb = __builtin_amdgcn_fdot2_f32_bf16(__builtin_shufflevector(uf, uf, 16 + 2 * (I), 17 + 2 * (I)), __builtin_bit_cast(bf16x2, hvb[I]), sb, false);
        U_PAIR(s0, 0, 0) U_PAIR(s0, 1, 0) U_PAIR(s0, 2, 0) U_PAIR(s0, 3, 0) U_PAIR(s0, 4, 0) U_PAIR(s0, 5, 0) U_PAIR(s0, 6, 0) U_PAIR(s0, 7, 0)
        __builtin_amdgcn_sched_barrier(0);
        LD_GROUP(s0, rsrc, tn, 0);
        __builtin_amdgcn_sched_barrier(0);
        U_PAIR(s1, 0, 16) U_PAIR(s1, 1, 16) U_PAIR(s1, 2, 16) U_PAIR(s1, 3, 16) U_PAIR(s1, 4, 16) U_PAIR(s1, 5, 16) U_PAIR(s1, 6, 16) U_PAIR(s1, 7, 16)
#undef U_DOT
#undef U_PAIR
        {
          const bool b3 = (lane & 8) != 0, b2 = (lane & 4) != 0, b1 = (lane & 2) != 0, b0 = (lane & 1) != 0;
          float A8[16], A4[8], A2[4], A1[2];
#pragma unroll
          for (int n = 0; n < 16; ++n) { const float snd = b3 ? P[n] : P[n + 16], kp = b3 ? P[n + 16] : P[n]; A8[n] = kp + shx<8>(snd); }
#pragma unroll
          for (int n = 0; n < 8; ++n) { const float snd = b2 ? A8[n] : A8[n + 8], kp = b2 ? A8[n + 8] : A8[n]; A4[n] = kp + shx<4>(snd); }
#pragma unroll
          for (int n = 0; n < 4; ++n) { const float snd = b1 ? A4[n] : A4[n + 4], kp = b1 ? A4[n + 4] : A4[n]; A2[n] = kp + shx<2>(snd); }
#pragma unroll
          for (int n = 0; n < 2; ++n) { const float snd = b0 ? A2[n] : A2[n + 2], kp = b0 ? A2[n + 2] : A2[n]; A1[n] = kp + shx<1>(snd); }
          float2* hp = (float2*)(hacc + t * 128 + g4 * 32 + 2 * q);
          if (c == 0) *hp = make_float2(A1[0], A1[1]);
          else { const float2 o = *hp; *hp = make_float2(o.x + A1[0], o.y + A1[1]); }
        }
#pragma unroll
        for (int j = 0; j < 4; ++j) hx[j] = hxn[j];
      }
    }
  }
  if (active) {
    float gv[32];
#pragma unroll
    for (int i = 0; i < 16; ++i) {
      const float* go = (const float*)(R4 + (size_t)(wave + 8 * i) * 1024 + 512);
#pragma unroll
      for (int r = 0; r < 2; ++r) {
        const int pos = lane + 64 * r, w = pos & 31;
        gv[2 * i + r] = go[8 * (w >> 1) + 4 * (w & 1) + (pos >> 5)];
      }
    }
#pragma unroll
    for (int i = 0; i < 16; ++i) {
      const int t = wave + 8 * i;
      const float rs = rsvG[t];
#pragma unroll
      for (int r = 0; r < 2; ++r) {
        const int pos = lane + 64 * r;
        const float am = hacc[t * 128 + pos] * rs * (1.f / 48.f);
        hacc[t * 128 + pos] = gv[2 * i + r] * 0.5f * am * (1.f + erf_as(am * 0.7071067811865476f)) * (1.f / 6.f);
      }
    }
  }
#pragma unroll 1
  for (int c = 0; c < 4; ++c) {
    if (active) {
      const __amdgpu_buffer_rsrc_t rsrc = mkrsrc(vtab + (size_t)c * NEXP * 192);
      u32x3 s0[16], s1[16];
      LD_GROUP(s0, rsrc, wave, 0);
#pragma unroll 1
      for (int i = 0; i < 16; ++i) {
        const int t = wave + 8 * i, tn = wave + 8 * (i < 15 ? i + 1 : 15);
        LD_GROUP(s1, rsrc, t, 1);
        GAS u32x2* xp = (GAS u32x2*)(xs + (size_t)t * DM) + 64 * c + lane;
        const u32x2 xw = *xp;
        f32x4 xo = {bflo(xw.x), bfhi(xw.x), bflo(xw.y), bfhi(xw.y)};
        f32x16 ov;
#pragma unroll
        for (int k = 0; k < 16; ++k) ov[k] = 0.f;
#define V_PAIR(S_, pp_, cfa_, cfb_) { \
          u32x6 w_ = (u32x6){S_[2 * (pp_)].x, S_[2 * (pp_)].y, S_[2 * (pp_)].z, S_[2 * (pp_) + 1].x, S_[2 * (pp_) + 1].y, S_[2 * (pp_) + 1].z}; \
          asm volatile("" : "+v"(w_)); \
          const f32x32 vf = __builtin_amdgcn_cvt_scalef32_pk32_f32_fp6(w_, 1.0f); \
          ov += __builtin_shufflevector(vf, vf, 0, 1, 2, 3, 4, 5, 6, 7, 8, 9, 10, 11, 12, 13, 14, 15) * (cfa_); \
          ov += __builtin_shufflevector(vf, vf, 16, 17, 18, 19, 20, 21, 22, 23, 24, 25, 26, 27, 28, 29, 30, 31) * (cfb_); \
          __builtin_amdgcn_sched_barrier(0); }
        {
          const float4* cp = (const float4*)(hacc + t * 128 + g4 * 32);
          const float4 c0 = cp[0], c1 = cp[1], c2 = cp[2], c3 = cp[3];
          V_PAIR(s0, 0, c0.x, c0.y) V_PAIR(s0, 1, c0.z, c0.w) V_PAIR(s0, 2, c1.x, c1.y) V_PAIR(s0, 3, c1.z, c1.w)
          V_PAIR(s0, 4, c2.x, c2.y) V_PAIR(s0, 5, c2.z, c2.w) V_PAIR(s0, 6, c3.x, c3.y) V_PAIR(s0, 7, c3.z, c3.w)
        }
        __builtin_amdgcn_sched_barrier(0);
        LD_GROUP(s0, rsrc, tn, 0);
        __builtin_amdgcn_sched_barrier(0);
        {
          const float4* cp = (const float4*)(hacc + t * 128 + g4 * 32 + 16);
          const float4 c0 = cp[0], c1 = cp[1], c2 = cp[2], c3 = cp[3];
          V_PAIR(s1, 0, c0.x, c0.y) V_PAIR(s1, 1, c0.z, c0.w) V_PAIR(s1, 2, c1.x, c1.y) V_PAIR(s1, 3, c1.z, c1.w)
          V_PAIR(s1, 4, c2.x, c2.y) V_PAIR(s1, 5, c2.z, c2.w) V_PAIR(s1, 6, c3.x, c3.y) V_PAIR(s1, 7, c3.z, c3.w)
        }
#undef V_PAIR
        {
          const bool b5 = (lane & 32) != 0, b4 = (lane & 16) != 0;
          float B8[8], B4[4], os[16];
#pragma unroll
          for (int k = 0; k < 16; ++k) { os[k] = ov[k]; asm volatile("" : "+v"(os[k])); }
#pragma unroll
          for (int n = 0; n < 8; ++n) { const float snd = b5 ? os[n] : os[n + 8], kp = b5 ? os[n + 8] : os[n]; B8[n] = kp + shfl_idx(snd, lane ^ 32); }
#pragma unroll
          for (int n = 0; n < 4; ++n) { const float snd = b4 ? B8[n] : B8[n + 4], kp = b4 ? B8[n + 4] : B8[n]; B4[n] = kp + shx<16>(snd); }
          xo.x += B4[0]; xo.y += B4[1]; xo.z += B4[2]; xo.w += B4[3];
        }
        *xp = (u32x2){pk2(xo.x, xo.y), pk2(xo.z, xo.w)};
        const float sq = wave_sum(xo.x * xo.x + xo.y * xo.y + xo.z * xo.z + xo.w * xo.w);
        if (lane == 0) ssq[t] = (c == 0) ? sq : ssq[t] + sq;
      }
    }
  }
#undef LD_GROUP
#undef SEG_LD
  if (active) {
    float4 gg[4];
#pragma unroll
    for (int j = 0; j < 4; ++j) gg[j] = last ? ((const float4*)p.g_final)[lane + 64 * j] : ((const float4*)(p.g_mix + (l + 1) * DM))[lane + 64 * j];
#define FIN_LOAD(buf_, i_) { const uint2* xr_ = (const uint2*)(xs + (size_t)(wave + 8 * (i_)) * DM); _Pragma("unroll") for (int j = 0; j < 4; ++j) buf_[j] = xr_[lane + 64 * j]; }
#define FIN_STORE(buf_, i_) { const int t_ = wave + 8 * (i_); const float r3_ = rsqrtf(ssq[t_] * (1.f / DM) + EPS); \
      if (last) { float4* xw_ = (float4*)(xout + (size_t)t_ * DM); \
        _Pragma("unroll") for (int j = 0; j < 4; ++j) xw_[lane + 64 * j] = make_float4(bflo(buf_[j].x) * r3_ * gg[j].x, bfhi(buf_[j].x) * r3_ * gg[j].y, bflo(buf_[j].y) * r3_ * gg[j].z, bfhi(buf_[j].y) * r3_ * gg[j].w); } \
      else { uint2* ho_ = (uint2*)(R1 + (size_t)t_ * DM) + lane; \
        _Pragma("unroll") for (int j = 0; j < 4; ++j) ho_[64 * j] = make_uint2(pk2(bflo(buf_[j].x) * r3_ * gg[j].x, bfhi(buf_[j].x) * r3_ * gg[j].y), pk2(bflo(buf_[j].y) * r3_ * gg[j].z, bfhi(buf_[j].y) * r3_ * gg[j].w)); } }
    uint2 xa[4], xb[4];
    FIN_LOAD(xa, 0);
    const int nstream = last ? 8 : 16;
#pragma unroll 1
    for (int i = 0; i < nstream; i += 2) {
      FIN_LOAD(xb, i + 1);
      FIN_STORE(xa, i);
      if (i + 2 < nstream) FIN_LOAD(xa, i + 2);
      FIN_STORE(xb, i + 1);
    }
    if (last) {
      uint2 xr[8][4];
#pragma unroll
      for (int i = 0; i < 8; ++i) FIN_LOAD(xr[i], 8 + i);
      asm volatile("s_waitcnt vmcnt(0)" ::: "memory");
      __syncthreads();
#pragma unroll
      for (int i = 0; i < 8; ++i) FIN_STORE(xr[i], 8 + i);
    }
#undef FIN_LOAD
#undef FIN_STORE
  }
  __syncthreads();
}

__global__ void __launch_bounds__(NT) fwd_mega(Params p) {
  cg::grid_group grid = cg::this_grid();
  __shared__ __attribute__((aligned(16))) unsigned char lds[LDS_BYTES];
  unsigned char* ws = p.ws;

  phase0(p, lds);
  grid_barrier(grid);

  for (int job = blockIdx.x; job < 64; job += gridDim.x) memkv_job(p, lds, job);
  unsigned* bar = (unsigned*)(ws + WS_BAR);
  unsigned nbar = 0;
  const int iters = (NTILES + (int)gridDim.x - 1) / (int)gridDim.x;
#pragma unroll 1
  for (int st = 0; st < 3; ++st) {
#pragma unroll 1
    for (int it = 0; it < iters; ++it) {
      const int tile0 = (int)blockIdx.x + it * (int)gridDim.x;
      const bool act = tile0 < NTILES;
      const int tile = act ? tile0 : 0;
      if (st > 0) {
        if (act) phaseC_tile(p, lds, st - 1, tile, st == 2);
        peer_gather(p, lds, st - 1, tile, st == 2, act, bar, nbar);
      }
      if (act) {
        if (st == 0) rmsnorm_tile(p.x + (size_t)tile * 128 * DM, p.g_mix, (u16*)(ws + WS_KVLOC + (size_t)tile * 256 * 1024));
        if (st < 2) phaseA_tile(p, lds, st, tile);
      }
    }
    if (st < 2) {
      grid_barrier_ctr(bar, (unsigned)gridDim.x * (++nbar));
      if (st == 0) for (int job = blockIdx.x; job < 128; job += gridDim.x) { if (job < 64) foldv_job(p, lds, job); else foldq_job(p, lds, job - 64); }
      phaseB(p, lds);
      grid_barrier_ctr(bar, (unsigned)gridDim.x * (++nbar));
    }
  }
}

extern "C" void kernel_launch(void* const* d_in, const int* in_sizes, int n_in, void* d_out, int out_size, void* d_ws, size_t ws_size, hipStream_t stream) {
  static int grid_blocks = 0;
  if (!grid_blocks) {
    int dev = 0, cus = 0, per_cu = 0;
    (void)hipGetDevice(&dev);
    (void)hipDeviceGetAttribute(&cus, hipDeviceAttributeMultiprocessorCount, dev);
    (void)hipOccupancyMaxActiveBlocksPerMultiprocessor(&per_cu, fwd_mega, NT, 0);
    if (per_cu < 1) { fprintf(stderr, "kernel_launch: occupancy query says %d blocks/CU\n", per_cu); per_cu = 1; }
    grid_blocks = cus < NTILES ? cus : NTILES;
    if (ws_size < WS_END || n_in != 21 || out_size != NTOK * DM) { fprintf(stderr, "kernel_launch: bad sizes ws=%zu need=%zu n_in=%d out=%d\n", ws_size, (size_t)WS_END, n_in, out_size); grid_blocks = -1; }
  }
  if (grid_blocks < 0) return;
  Params p{};
  const float** pp = (const float**)&p;
  for (int i = 0; i < 21; ++i) pp[i] = (const float*)d_in[i];
  p.out = (float*)d_out; p.ws = (unsigned char*)d_ws;
  (void)hipMemsetAsync((unsigned char*)d_ws + WS_BAR, 0, 4096, stream);
  void* args[] = {&p};
  hipError_t e = hipLaunchCooperativeKernel((void*)fwd_mega, dim3(grid_blocks), dim3(NT), args, 0, stream);
  if (e != hipSuccess) fprintf(stderr, "cooperative launch failed: %s (grid %d)\n", hipGetErrorString(e), grid_blocks);
}
```

```cpp
#include <hip/hip_runtime.h>
#include <hip/hip_cooperative_groups.h>
#include <cstdio>
#include <cstdint>
namespace cg = cooperative_groups;

typedef unsigned short u16;
typedef __attribute__((ext_vector_type(8))) __bf16 bf16x8;
typedef __attribute__((ext_vector_type(2))) __bf16 bf16x2;
typedef __attribute__((ext_vector_type(2))) float f32x2;
typedef __attribute__((ext_vector_type(16))) float f32x16;
typedef __attribute__((ext_vector_type(4))) unsigned int u32x4;
typedef __attribute__((ext_vector_type(2))) unsigned int u32x2;
typedef __attribute__((ext_vector_type(6))) unsigned int u32x6;
typedef __attribute__((ext_vector_type(3))) unsigned int u32x3;
typedef __attribute__((ext_vector_type(4))) float f32x4;
typedef __attribute__((ext_vector_type(32))) float f32x32;
typedef __attribute__((ext_vector_type(32))) __bf16 bf16x32;
typedef __attribute__((ext_vector_type(16))) unsigned int u32x16;

#define DEV __device__ __forceinline__
#define FP6_INTERLEAVED 1
#define GAS __attribute__((address_space(1)))

constexpr int DM = 1024;
constexpr int NTOK = 32768;
constexpr int NTILES = 256;
constexpr int NIN = 3584;
constexpr int NINP = 3616;
constexpr int NEXP = 16384;
constexpr int NT = 512;
constexpr float EPS = 1e-6f;

constexpr size_t MiB = 1024 * 1024;
constexpr size_t WS_WT_IN = 0;
constexpr size_t SZ_WT_IN1 = (size_t)NINP * 1024 * 2;
constexpr size_t WS_WT_OUT = WS_WT_IN + 2 * SZ_WT_IN1;
constexpr size_t WS_WT_XQ = WS_WT_OUT + 4 * MiB;
constexpr size_t WS_WT_XK = WS_WT_XQ + 4 * MiB;
constexpr size_t WS_WT_XV = WS_WT_XK + 4 * MiB;
constexpr size_t WS_WT_XO = WS_WT_XV + 4 * MiB;
constexpr size_t WS_WT_PQ = WS_WT_XO + 4 * MiB;
constexpr size_t WS_SKT = WS_WT_PQ + 8 * MiB;
constexpr size_t WS_MEMN = WS_SKT + 2 * MiB;
constexpr size_t WS_MEMK = WS_MEMN + 2 * MiB;
constexpr size_t WS_MEMVT = WS_MEMK + 2 * MiB;
constexpr size_t WS_GATES = WS_MEMVT + 2 * MiB;
constexpr size_t WS_BCUM = WS_GATES + 1 * MiB;
constexpr size_t WS_NLOC = WS_BCUM + 512 * 1024;
constexpr size_t WS_NSTATE = WS_NLOC + 512 * 1024;
constexpr size_t WS_MLOC = WS_NSTATE + 512 * 1024;
constexpr size_t WS_BL = WS_MLOC + 4096;
constexpr size_t WS_MSTATE = WS_BL + 4096;
constexpr size_t WS_HALO = WS_MSTATE + 4096;
constexpr size_t WS_Z = WS_HALO + 2 * MiB;
constexpr size_t WS_KT = WS_Z + (size_t)NTOK * NIN * 2;
constexpr size_t WS_VT = WS_KT + 32 * MiB;
constexpr size_t WS_KVLOC = WS_VT + 32 * MiB;
constexpr size_t WS_CSTATE = WS_KVLOC + 64 * MiB;
constexpr size_t WS_EXP6 = WS_CSTATE + 32 * MiB;
constexpr size_t WS_BAR = WS_EXP6 + 48 * MiB;
constexpr size_t WS_WT_MO = WS_BAR + 4096;
constexpr size_t WS_WT_MQ = WS_WT_MO + 8 * MiB;
constexpr size_t WS_END = WS_WT_MQ + 8 * MiB;

constexpr size_t ZSLOT = (size_t)128 * NIN * 2;
constexpr size_t R2_OFF = 0, R3_OFF = 256 * 1024, R4_OFF = 768 * 1024;

constexpr int LDS_BYTES = 131072 + 1024;

struct Params {
  const float *x, *mem, *g_mix, *w_in, *b_if, *conv_w, *conv_b, *g_head, *w_out, *g_xattn, *g_mem;
  const float *w_xq, *w_xk, *w_xv, *w_xo, *g_ffn, *w_pq, *sub_keys, *u_exp, *v_exp, *g_final;
  float* out;
  unsigned char* ws;
};

DEV int opaque_tid() { int t = threadIdx.x; asm volatile("" : "+v"(t)); return t; }
DEV unsigned char* opaque_ptr(unsigned char* q) { GAS unsigned char* g = (GAS unsigned char*)q; asm volatile("" : "+s"(g)); return (unsigned char*)g; }
DEV float bf2f(u16 v) { return __uint_as_float(((unsigned)v) << 16); }
DEV unsigned pk2(float lo, float hi) { f32x2 v = {lo, hi}; bf16x2 b = __builtin_convertvector(v, bf16x2); return __builtin_bit_cast(unsigned, b); }
DEV u16 f2bf(float f) { return (u16)(pk2(f, 0.f) & 0xffffu); }
template <int M> DEV float shx(float v) {
  if constexpr (M == 32) return __shfl_xor(v, 32);
  else return __builtin_bit_cast(float, __builtin_amdgcn_ds_swizzle(__builtin_bit_cast(int, v), (M << 10) | 0x1F));
}
DEV float shfl_idx(float v, int srclane) { return __builtin_bit_cast(float, __builtin_amdgcn_ds_bpermute(srclane << 2, __builtin_bit_cast(int, v))); }
DEV float wave_sum(float v) { v += shx<32>(v); v += shx<16>(v); v += shx<8>(v); v += shx<4>(v); v += shx<2>(v); v += shx<1>(v); return v; }
DEV float wave_max(float v) { v = fmaxf(v, shx<32>(v)); v = fmaxf(v, shx<16>(v)); v = fmaxf(v, shx<8>(v)); v = fmaxf(v, shx<4>(v)); v = fmaxf(v, shx<2>(v)); v = fmaxf(v, shx<1>(v)); return v; }
DEV __amdgpu_buffer_rsrc_t mkrsrc(const void* p) { return __builtin_amdgcn_make_buffer_rsrc((void*)p, 0, 0x7fffffff, 0x00020000); }
DEV int rowmap(int reg, int lane) { return (reg & 3) + 8 * (reg >> 2) + 4 * (lane >> 5); }
DEV f32x16 zero16() { f32x16 z;
#pragma unroll
  for (int i = 0; i < 16; ++i) z[i] = 0.f;
  return z; }
DEV bf16x8 ld_frag(const unsigned char* p) { return *(const bf16x8*)p; }
DEV bf16x8 ld_frag_g(const u16* p) { uint4 v = *(const uint4*)p; return __builtin_bit_cast(bf16x8, v); }
DEV float bflo(unsigned w) { return __uint_as_float(w << 16); }
DEV float bfhi(unsigned w) { return __uint_as_float(w & 0xffff0000u); }

DEV void rmsnorm_tile(const float* src, const float* g, u16* dst) {
  const int tid = opaque_tid(), wave = tid >> 6, lane = tid & 63;
  const float4* gr = (const float4*)g + lane;
  float4 gg[4];
#pragma unroll
  for (int j = 0; j < 4; ++j) gg[j] = gr[64 * j];
#pragma unroll 1
  for (int r0 = wave * 16; r0 < wave * 16 + 16; r0 += 4) {
    float4 v[4][4]; float ss[4];
#pragma unroll
    for (int q = 0; q < 4; ++q) {
      const float4* xr = (const float4*)(src + (size_t)(r0 + q) * DM) + lane;
#pragma unroll
      for (int j = 0; j < 4; ++j) v[q][j] = xr[64 * j];
    }
#pragma unroll
    for (int q = 0; q < 4; ++q) {
      float s = 0.f;
#pragma unroll
      for (int j = 0; j < 4; ++j) s += v[q][j].x * v[q][j].x + v[q][j].y * v[q][j].y + v[q][j].z * v[q][j].z + v[q][j].w * v[q][j].w;
      ss[q] = s;
    }
#pragma unroll
    for (int q = 0; q < 4; ++q) ss[q] = wave_sum(ss[q]);
#pragma unroll
    for (int q = 0; q < 4; ++q) {
      const float rs = rsqrtf(ss[q] * (1.f / DM) + EPS);
      uint2* o = (uint2*)(dst + (size_t)(r0 + q) * DM) + lane;
#pragma unroll
      for (int j = 0; j < 4; ++j) o[64 * j] = make_uint2(pk2(v[q][j].x * rs * gg[j].x, v[q][j].y * rs * gg[j].y), pk2(v[q][j].z * rs * gg[j].z, v[q][j].w * rs * gg[j].w));
    }
  }
}

struct TileDesc { const u16* A; int lda; const u16* B; int ldb; int kb; };
constexpr int G_STAGE = 55296, G_BOFF = 18432, G_PITCH = 144;

#define GEMM_LOAD(ra, rb, s_)                                                                                  \
  {                                                                                                            \
    const int j_ = (s_) / KS, kk_ = (s_) % KS;                                                                  \
    const TileDesc d_ = descf(j_);                                                                              \
    const __amdgpu_buffer_rsrc_t rsA_ = mkrsrc(d_.A), rsB_ = mkrsrc(d_.B);                                      \
    const int voA_ = ((tid >> 3) * d_.lda + (tid & 7) * 8) * 2, voB_ = ((tid >> 3) * d_.ldb + (tid & 7) * 8) * 2; \
    _Pragma("unroll") for (int i = 0; i < 2; ++i) ra[i] = __builtin_amdgcn_raw_buffer_load_b128(rsA_, voA_, (kk_ * 64 + i * 64 * d_.lda) * 2, 0); \
    _Pragma("unroll") for (int i = 0; i < 4; ++i) rb[i] = __builtin_amdgcn_raw_buffer_load_b128(rsB_, voB_, (kk_ * 64 + i * 64 * d_.ldb) * 2, 0); \
  }
#define GEMM_STORE(ra, rb, buf_)                                                                               \
  {                                                                                                            \
    unsigned char* base_ = lds + (buf_) * G_STAGE + (tid >> 3) * G_PITCH + (tid & 7) * 16;                      \
    _Pragma("unroll") for (int i = 0; i < 2; ++i) *(u32x4*)(base_ + i * 64 * G_PITCH) = ra[i];                  \
    _Pragma("unroll") for (int i = 0; i < 4; ++i) *(u32x4*)(base_ + G_BOFF + i * 64 * G_PITCH) = rb[i];         \
  }
#define GEMM_COMPUTE(buf_)                                                                                     \
  {                                                                                                            \
    const unsigned char* st = lds + (buf_) * G_STAGE;                                                           \
    _Pragma("unroll") for (int ks = 0; ks < 4; ++ks) {                                                          \
      const bf16x8 a0 = ld_frag(st + aoff + ks * 32), a1 = ld_frag(st + aoff + 32 * G_PITCH + ks * 32);         \
      const bf16x8 b0 = ld_frag(st + boff + ks * 32), b1 = ld_frag(st + boff + 32 * G_PITCH + ks * 32);         \
      acc[0][0] = __builtin_amdgcn_mfma_f32_32x32x16_bf16(a0, b0, acc[0][0], 0, 0, 0);                          \
      acc[0][1] = __builtin_amdgcn_mfma_f32_32x32x16_bf16(a0, b1, acc[0][1], 0, 0, 0);                          \
      acc[1][0] = __builtin_amdgcn_mfma_f32_32x32x16_bf16(a1, b0, acc[1][0], 0, 0, 0);                          \
      acc[1][1] = __builtin_amdgcn_mfma_f32_32x32x16_bf16(a1, b1, acc[1][1], 0, 0, 0);                          \
    }                                                                                                           \
  }
#define GEMM_EPI(s_)                                                                                           \
  if (((s_) % KS) == KS - 1) {                                                                                 \
    epif((s_) / KS, acc, wm, wn, lane);                                                                         \
    _Pragma("unroll") for (int a = 0; a < 2; ++a) _Pragma("unroll") for (int b = 0; b < 2; ++b) acc[a][b] = zero16(); \
  }

#define LC_LOAD(ra, rb, s_)                                                                                    \
  {                                                                                                            \
    const int j_ = (s_) / KS, kk_ = ((s_) + krot) % KS;                                                                  \
    const TileDesc d_ = descf(j_);                                                                              \
    const __amdgpu_buffer_rsrc_t rsA_ = mkrsrc(d_.A), rsB_ = mkrsrc(d_.B);                                      \
    const int voA_ = ((lt >> 3) * d_.lda + (lt & 7) * 8) * 2, voB_ = ((lt >> 3) * d_.ldb + (lt & 7) * 8) * 2;   \
    _Pragma("unroll") for (int i = 0; i < 4; ++i) ra[i] = __builtin_amdgcn_raw_buffer_load_b128(rsA_, voA_, (kk_ * 64 + ((i + rot) & 3) * 32 * d_.lda) * 2, 0); \
    _Pragma("unroll") for (int i = 0; i < 8; ++i) rb[i] = __builtin_amdgcn_raw_buffer_load_b128(rsB_, voB_, (kk_ * d_.kb + ((i + rot) & 7) * 32 * d_.ldb) * 2, 0); \
  }
#define LC_LOADC(ra, rb, s_) { const int sn_ = ((s_) < total) ? (s_) : total - 1; LC_LOAD(ra, rb, sn_); }
#define LC_STORE(ra, rb, buf_)                                                                                 \
  {                                                                                                            \
    unsigned char* base_ = lds + (buf_) * G_STAGE + (lt >> 3) * G_PITCH + (lt & 7) * 16;                        \
    _Pragma("unroll") for (int i = 0; i < 4; ++i) *(u32x4*)(base_ + ((i + rot) & 3) * 32 * G_PITCH) = ra[i];                  \
    _Pragma("unroll") for (int i = 0; i < 8; ++i) *(u32x4*)(base_ + G_BOFF + ((i + rot) & 7) * 32 * G_PITCH) = rb[i];         \
  }
#define LC_COMPUTE(buf_)                                                                                       \
  {                                                                                                            \
    const unsigned char* st = lds + (buf_) * G_STAGE;                                                           \
    _Pragma("unroll") for (int ks = 0; ks < 4; ++ks) {                                                          \
      const bf16x8 a0 = ld_frag(st + aoff + ks * 32), a1 = ld_frag(st + aoff + 32 * G_PITCH + ks * 32);         \
      _Pragma("unroll") for (int ni = 0; ni < 4; ++ni) {                                                        \
        const bf16x8 b = ld_frag(st + boff + ni * 32 * G_PITCH + ks * 32);                                      \
        if constexpr (SW) { acc[0][ni] = __builtin_amdgcn_mfma_f32_32x32x16_bf16(b, a0, acc[0][ni], 0, 0, 0); acc[1][ni] = __builtin_amdgcn_mfma_f32_32x32x16_bf16(b, a1, acc[1][ni], 0, 0, 0); } \
        else { acc[0][ni] = __builtin_amdgcn_mfma_f32_32x32x16_bf16(a0, b, acc[0][ni], 0, 0, 0); acc[1][ni] = __builtin_amdgcn_mfma_f32_32x32x16_bf16(a1, b, acc[1][ni], 0, 0, 0); } \
      }                                                                                                         \
    }                                                                                                           \
  }
#define LC_EPI(s_)                                                                                             \
  if (((s_) % KS) == KS - 1) {                                                                                 \
    epif((s_) / KS, acc, wm, wn, lane);                                                                         \
    _Pragma("unroll") for (int a = 0; a < 2; ++a) _Pragma("unroll") for (int b = 0; b < 4; ++b) acc[a][b] = zero16(); \
  }
#define LDS_BARRIER() do { asm volatile("s_waitcnt lgkmcnt(0)" ::: "memory"); __builtin_amdgcn_s_barrier(); asm volatile("" ::: "memory"); } while (0)

template <int KS, int EB = 0, bool SW = false, class DescF, class EpiF>
DEV void gemm_run(unsigned char* lds, int ntiles, DescF descf, EpiF epif) {
  const int tid = opaque_tid(), lane = tid & 63, wave = __builtin_amdgcn_readfirstlane(tid >> 6);
  const int total = ntiles * KS;
  __syncthreads();
  if (wave >= 4) {
    const int lt = tid - 256;
    const int krot = (9 * (__builtin_amdgcn_readfirstlane((int)blockIdx.x) >> 3) + 15 * (__builtin_amdgcn_readfirstlane((int)blockIdx.x) & 7)) & (KS - 1);
    const int rot = __builtin_amdgcn_readfirstlane((int)blockIdx.x) & 7;
    u32x4 ra0[4], rb0[8], ra1[4], rb1[8], ra2[4], rb2[8], ra3[4], rb3[8];
    LC_LOAD(ra0, rb0, 0);
    LC_LOAD(ra1, rb1, 1);
    LC_LOAD(ra2, rb2, 2);
    LC_LOAD(ra3, rb3, 3);
    LC_STORE(ra0, rb0, 0);
    LC_LOADC(ra0, rb0, 4);
    LDS_BARRIER();
#pragma unroll 1
    for (int s = 0; s < total; s += 4) {
#define LC_EB(s_) if (EB > 0 && ((s_) % KS) == KS - 1) { _Pragma("unroll") for (int eb = 0; eb < EB; ++eb) LDS_BARRIER(); }
      LC_STORE(ra1, rb1, 1); LC_LOADC(ra1, rb1, s + 5); LC_EB(s);     LDS_BARRIER();
      LC_STORE(ra2, rb2, 0); LC_LOADC(ra2, rb2, s + 6); LC_EB(s + 1); LDS_BARRIER();
      LC_STORE(ra3, rb3, 1); LC_LOADC(ra3, rb3, s + 7); LC_EB(s + 2); LDS_BARRIER();
      LC_STORE(ra0, rb0, 0); LC_LOADC(ra0, rb0, s + 8); LC_EB(s + 3); LDS_BARRIER();
#undef LC_EB
    }
  } else {
    const int wm = wave >> 1, wn = wave & 1;
    f32x16 acc[2][4];
#pragma unroll
    for (int a = 0; a < 2; ++a)
#pragma unroll
      for (int b = 0; b < 4; ++b) acc[a][b] = zero16();
    const int aoff = (wm * 64 + (lane & 31)) * G_PITCH + (lane >> 5) * 16;
    const int boff = G_BOFF + (wn * 128 + (lane & 31)) * G_PITCH + (lane >> 5) * 16;
    LDS_BARRIER();
    __builtin_amdgcn_s_setprio(2);
#pragma unroll 1
    for (int s = 0; s < total; s += 2) {
      LC_COMPUTE(0); LC_EPI(s);     LDS_BARRIER();
      LC_COMPUTE(1); LC_EPI(s + 1); LDS_BARRIER();
    }
    __builtin_amdgcn_s_setprio(0);
  }
  __syncthreads();
}

DEV void epi_store_bf16(const f32x16 (&acc)[2][4], int wm, int wn, int lane, u16* dst, int ld, int col0, float scale) {
  const __amdgpu_buffer_rsrc_t rs = mkrsrc(dst);
  const int voff = (4 * (lane >> 5) * ld + (lane & 31)) * 2;
#pragma unroll
  for (int mi = 0; mi < 2; ++mi)
#pragma unroll
    for (int ni = 0; ni < 4; ++ni)
#pragma unroll
      for (int r = 0; r < 16; ++r) {
        const int soff = ((wm * 64 + mi * 32 + (r & 3) + 8 * (r >> 2)) * ld + col0 + wn * 128 + ni * 32) * 2;
        __builtin_amdgcn_raw_buffer_store_b16(f2bf(acc[mi][ni][r] * scale), rs, voff, soff, 0);
      }
}
DEV void epi_store_u(const f32x16 (&acc)[2][4], int wm, int wn, int lane, u16* dst, int ld, int ucol0) {
  const __amdgpu_buffer_rsrc_t rs = mkrsrc(dst);
  const int voff = (4 * (lane >> 5) * ld + (lane & 31)) * 2;
#pragma unroll
  for (int mi = 0; mi < 2; ++mi)
#pragma unroll
    for (int pp = 0; pp < 2; ++pp)
#pragma unroll
      for (int r = 0; r < 16; ++r) {
        const int soff = ((wm * 64 + mi * 32 + (r & 3) + 8 * (r >> 2)) * ld + ucol0 + wn * 64 + pp * 32) * 2;
        __builtin_amdgcn_raw_buffer_store_b16(f2bf(acc[mi][2 * pp][r] * acc[mi][2 * pp + 1][r]), rs, voff, soff, 0);
      }
}
DEV void epi_store_f32(const f32x16 (&acc)[2][4], int wm, int wn, int lane, float* dst, int ld, int col0, float scale) {
  const __amdgpu_buffer_rsrc_t rs = mkrsrc(dst);
  const int voff = (4 * (lane >> 5) * ld + (lane & 31)) * 4;
#pragma unroll
  for (int mi = 0; mi < 2; ++mi)
#pragma unroll
    for (int ni = 0; ni < 4; ++ni)
#pragma unroll
      for (int r = 0; r < 16; ++r) {
        const int soff = ((wm * 64 + mi * 32 + (r & 3) + 8 * (r >> 2)) * ld + col0 + wn * 128 + ni * 32) * 4;
        __builtin_amdgcn_raw_buffer_store_b32(__float_as_uint(acc[mi][ni][r] * scale), rs, voff, soff, 0);
      }
}
DEV void epi_residual_norm(const f32x16 (&acc)[2][4], int wm, int wn, int lane, const void* src, bool src32, u16* dst, int col0, const float* g, u16* xg, float* rowss) {
  const __amdgpu_buffer_rsrc_t rsS = mkrsrc(src), rsD = mkrsrc(dst), rsX = mkrsrc(xg);
  const int voff = (4 * (lane >> 5) * DM + (lane & 31)) * 4;
  const int voffx = (4 * (lane >> 5) * DM + (lane & 31)) * 2;
#pragma unroll
  for (int mi = 0; mi < 2; ++mi) {
    float s[16];
#pragma unroll
    for (int ni = 0; ni < 4; ++ni) {
      float xv[16];
      const float gq = xg ? g[col0 + wn * 128 + ni * 32 + (lane & 31)] : 0.f;
      if (src32) {
#pragma unroll
        for (int r = 0; r < 16; ++r) {
          const int soff = ((wm * 64 + mi * 32 + (r & 3) + 8 * (r >> 2)) * DM + col0 + wn * 128 + ni * 32) * 4;
          xv[r] = __uint_as_float(__builtin_amdgcn_raw_buffer_load_b32(rsS, voff, soff, 0));
        }
      } else {
#pragma unroll
        for (int r = 0; r < 16; ++r) {
          const int soff = ((wm * 64 + mi * 32 + (r & 3) + 8 * (r >> 2)) * DM + col0 + wn * 128 + ni * 32) * 2;
          xv[r] = bf2f((u16)__builtin_amdgcn_raw_buffer_load_b16(rsS, voffx, soff, 0));
        }
      }
#pragma unroll
      for (int r = 0; r < 16; ++r) {
        const float v0 = xv[r] + acc[mi][ni][r];
        const int so = ((wm * 64 + mi * 32 + (r & 3) + 8 * (r >> 2)) * DM + col0 + wn * 128 + ni * 32);
        __builtin_amdgcn_raw_buffer_store_b16(f2bf(v0), rsD, voffx, so * 2, 0);
        if (xg) __builtin_amdgcn_raw_buffer_store_b16(f2bf(v0 * gq), rsX, voffx, so * 2, 0);
        s[r] = ni ? s[r] + v0 * v0 : v0 * v0;
      }
    }
    float t8[8], t4[4], t2[2], t1;
    const bool b4 = (lane & 16) != 0, b3 = (lane & 8) != 0, b2 = (lane & 4) != 0, b1 = (lane & 2) != 0;
#pragma unroll
    for (int q = 0; q < 8; ++q) { const float snd = b4 ? s[q] : s[q + 8], kp = b4 ? s[q + 8] : s[q]; t8[q] = kp + shx<16>(snd); }
#pragma unroll
    for (int q = 0; q < 4; ++q) { const float snd = b3 ? t8[q] : t8[q + 4], kp = b3 ? t8[q + 4] : t8[q]; t4[q] = kp + shx<8>(snd); }
#pragma unroll
    for (int q = 0; q < 2; ++q) { const float snd = b2 ? t4[q] : t4[q + 2], kp = b2 ? t4[q + 2] : t4[q]; t2[q] = kp + shx<4>(snd); }
    { const float snd = b1 ? t2[0] : t2[1], kp = b1 ? t2[1] : t2[0]; t1 = kp + shx<2>(snd); }
    t1 += shx<1>(t1);
    if ((lane & 1) == 0) {
      const int r = (lane >> 1) & 15;
      rowss[((col0 >> 8) * 2 + wn) * 128 + wm * 64 + mi * 32 + (r & 3) + 8 * (r >> 2) + 4 * (lane >> 5)] = t1;
    }
  }
}
DEV void epi_store_bf16_rows(const f32x16 (&acc)[2][4], int wm, int wn, int lane, u16* dst, int ld, int col0, const float* rsv) {
  const __amdgpu_buffer_rsrc_t rs = mkrsrc(dst);
  const int voff = (4 * (lane >> 5) * ld + (lane & 31)) * 2;
#pragma unroll
  for (int mi = 0; mi < 2; ++mi)
#pragma unroll
    for (int g = 0; g < 4; ++g) {
      const float4 sc4 = *(const float4*)(rsv + wm * 64 + mi * 32 + 8 * g + 4 * (lane >> 5));
      const float sc[4] = {sc4.x, sc4.y, sc4.z, sc4.w};
#pragma unroll
      for (int ni = 0; ni < 4; ++ni)
#pragma unroll
        for (int e = 0; e < 4; ++e) {
          const int soff = ((wm * 64 + mi * 32 + 8 * g + e) * ld + col0 + wn * 128 + ni * 32) * 2;
          __builtin_amdgcn_raw_buffer_store_b16(f2bf(acc[mi][ni][4 * g + e] * sc[e]), rs, voff, soff, 0);
        }
    }
}
DEV void epi_store_f32_rows(const f32x16 (&acc)[2][4], int wm, int wn, int lane, float* dst, int ld, int col0, const float* rsv) {
  const __amdgpu_buffer_rsrc_t rs = mkrsrc(dst);
  const int voff = (4 * (lane >> 5) * ld + (lane & 31)) * 4;
#pragma unroll
  for (int mi = 0; mi < 2; ++mi)
#pragma unroll
    for (int g = 0; g < 4; ++g) {
      const float4 sc4 = *(const float4*)(rsv + wm * 64 + mi * 32 + 8 * g + 4 * (lane >> 5));
      const float sc[4] = {sc4.x, sc4.y, sc4.z, sc4.w};
#pragma unroll
      for (int ni = 0; ni < 4; ++ni)
#pragma unroll
        for (int e = 0; e < 4; ++e) {
          const int soff = ((wm * 64 + mi * 32 + 8 * g + e) * ld + col0 + wn * 128 + ni * 32) * 4;
          __builtin_amdgcn_raw_buffer_store_b32(__float_as_uint(acc[mi][ni][4 * g + e] * sc[e]), rs, voff, soff, 0);
        }
    }
}
DEV void epi_store_bf16_T(const f32x16 (&acc)[2][4], int wm, int wn, int lane, u16* dst, int ldt, int colbase) {
  const __amdgpu_buffer_rsrc_t rs = mkrsrc(dst);
  const int voff = ((lane & 31) * ldt + 4 * (lane >> 5)) * 2;
#pragma unroll
  for (int mi = 0; mi < 2; ++mi)
#pragma unroll
    for (int ni = 0; ni < 4; ++ni)
#pragma unroll
      for (int g = 0; g < 4; ++g) {
        const int soff = ((colbase + wn * 128 + ni * 32) * ldt + wm * 64 + mi * 32 + 8 * g) * 2;
        u32x2 v; v.x = pk2(acc[mi][ni][4 * g], acc[mi][ni][4 * g + 1]); v.y = pk2(acc[mi][ni][4 * g + 2], acc[mi][ni][4 * g + 3]);
        __builtin_amdgcn_raw_buffer_store_b64(v, rs, voff, soff, 0);
      }
}

DEV void epi_store_tiled(const f32x16 (&acc)[2][4], int wm, int wn, int lane, u16* dst, int jn, int nbase, int kcol0, float scale) {
  const __amdgpu_buffer_rsrc_t rs = mkrsrc(dst);
  const int voff = (4 * (lane >> 5) * 64 + (lane & 31)) * 2;
#pragma unroll
  for (int mi = 0; mi < 2; ++mi)
#pragma unroll
    for (int ni = 0; ni < 4; ++ni)
#pragma unroll
      for (int r = 0; r < 16; ++r) {
        const int kc = kcol0 + wn * 128 + ni * 32;
        const int soff = ((jn * 16 + (kc >> 6)) * 16384 + (nbase + wm * 64 + mi * 32 + (r & 3) + 8 * (r >> 2)) * 64 + (kc & 63)) * 2;
        __builtin_amdgcn_raw_buffer_store_b16(f2bf(acc[mi][ni][r] * scale), rs, voff, soff, 0);
      }
}
DEV void epi_store_tiledT(const f32x16 (&acc)[2][4], int wm, int wn, int lane, u16* dst, int jn, int kbase) {
  const __amdgpu_buffer_rsrc_t rs = mkrsrc(dst);
  const int voff = ((lane & 31) * 64 + 4 * (lane >> 5)) * 2;
#pragma unroll
  for (int mi = 0; mi < 2; ++mi)
#pragma unroll
    for (int ni = 0; ni < 4; ++ni)
#pragma unroll
      for (int g = 0; g < 4; ++g) {
        const int k0 = kbase + wm * 64 + mi * 32 + 8 * g;
        const int soff = ((jn * 16 + (k0 >> 6)) * 16384 + (wn * 128 + ni * 32) * 64 + (k0 & 63)) * 2;
        u32x2 v; v.x = pk2(acc[mi][ni][4 * g], acc[mi][ni][4 * g + 1]); v.y = pk2(acc[mi][ni][4 * g + 2], acc[mi][ni][4 * g + 3]);
        __builtin_amdgcn_raw_buffer_store_b64(v, rs, voff, soff, 0);
      }
}

DEV void epi_softmax_bf16(const f32x16 (&acc)[2][4], int wm, int wn, int lane, u16* dst, int ld, int col0, const float* rsv, float* pm, float* ps) {
  const bool b4 = (lane & 16) != 0, b3 = (lane & 8) != 0, b2 = (lane & 4) != 0, b1 = (lane & 2) != 0;
  const int rsel = (lane >> 1) & 15;
  const int rrow = (rsel & 3) + 8 * (rsel >> 2) + 4 * (lane >> 5);
  float rsf[2][16];
#pragma unroll
  for (int mi = 0; mi < 2; ++mi)
#pragma unroll
    for (int g = 0; g < 4; ++g) {
      const float4 s4 = *(const float4*)(rsv + wm * 64 + mi * 32 + 8 * g + 4 * (lane >> 5));
      rsf[mi][4 * g] = s4.x; rsf[mi][4 * g + 1] = s4.y; rsf[mi][4 * g + 2] = s4.z; rsf[mi][4 * g + 3] = s4.w;
    }
#pragma unroll
  for (int mi = 0; mi < 2; ++mi) {
    float s[16];
#pragma unroll
    for (int r = 0; r < 16; ++r) s[r] = fmaxf(fmaxf(acc[mi][0][r], acc[mi][1][r]), fmaxf(acc[mi][2][r], acc[mi][3][r])) * rsf[mi][r];
    float t8[8], t4[4], t2[2], t1;
#pragma unroll
    for (int q = 0; q < 8; ++q) { const float snd = b4 ? s[q] : s[q + 8], kp = b4 ? s[q + 8] : s[q]; t8[q] = fmaxf(kp, shx<16>(snd)); }
#pragma unroll
    for (int q = 0; q < 4; ++q) { const float snd = b3 ? t8[q] : t8[q + 4], kp = b3 ? t8[q + 4] : t8[q]; t4[q] = fmaxf(kp, shx<8>(snd)); }
#pragma unroll
    for (int q = 0; q < 2; ++q) { const float snd = b2 ? t4[q] : t4[q + 2], kp = b2 ? t4[q + 2] : t4[q]; t2[q] = fmaxf(kp, shx<4>(snd)); }
    { const float snd = b1 ? t2[0] : t2[1], kp = b1 ? t2[1] : t2[0]; t1 = fmaxf(kp, shx<2>(snd)); }
    t1 = fmaxf(t1, shx<1>(t1));
    if ((lane & 1) == 0) pm[wn * 128 + wm * 64 + mi * 32 + rrow] = t1;
  }
  LDS_BARRIER();
#pragma unroll
  for (int mi = 0; mi < 2; ++mi) {
    float s[16];
#pragma unroll
    for (int g = 0; g < 4; ++g) {
      const int rb = wm * 64 + mi * 32 + 8 * g + 4 * (lane >> 5);
      const float4 m0 = *(const float4*)(pm + rb), m1 = *(const float4*)(pm + 128 + rb);
      const float mx[4] = {fmaxf(m0.x, m1.x), fmaxf(m0.y, m1.y), fmaxf(m0.z, m1.z), fmaxf(m0.w, m1.w)};
#pragma unroll
      for (int q = 0; q < 4; ++q) {
        float e = 0.f;
#pragma unroll
        for (int ni = 0; ni < 4; ++ni) e += __expf(acc[mi][ni][4 * g + q] * rsf[mi][4 * g + q] - mx[q]);
        s[4 * g + q] = e;
      }
    }
    float t8[8], t4[4], t2[2], t1;
#pragma unroll
    for (int q = 0; q < 8; ++q) { const float snd = b4 ? s[q] : s[q + 8], kp = b4 ? s[q + 8] : s[q]; t8[q] = kp + shx<16>(snd); }
#pragma unroll
    for (int q = 0; q < 4; ++q) { const float snd = b3 ? t8[q] : t8[q + 4], kp = b3 ? t8[q + 4] : t8[q]; t4[q] = kp + shx<8>(snd); }
#pragma unroll
    for (int q = 0; q < 2; ++q) { const float snd = b2 ? t4[q] : t4[q + 2], kp = b2 ? t4[q + 2] : t4[q]; t2[q] = kp + shx<4>(snd); }
    { const float snd = b1 ? t2[0] : t2[1], kp = b1 ? t2[1] : t2[0]; t1 = kp + shx<2>(snd); }
    t1 += shx<1>(t1);
    if ((lane & 1) == 0) ps[wn * 128 + wm * 64 + mi * 32 + rrow] = t1;
  }
  LDS_BARRIER();
  const __amdgpu_buffer_rsrc_t rs = mkrsrc(dst);
  const int voff = (4 * (lane >> 5) * ld + (lane & 31)) * 2;
#pragma unroll
  for (int mi = 0; mi < 2; ++mi)
#pragma unroll
    for (int g = 0; g < 4; ++g) {
      const int rb = wm * 64 + mi * 32 + 8 * g + 4 * (lane >> 5);
      const float4 m0 = *(const float4*)(pm + rb), m1 = *(const float4*)(pm + 128 + rb);
      const float mx[4] = {fmaxf(m0.x, m1.x), fmaxf(m0.y, m1.y), fmaxf(m0.z, m1.z), fmaxf(m0.w, m1.w)};
      const float4 s0 = *(const float4*)(ps + rb), s1 = *(const float4*)(ps + 128 + rb);
      const float inv[4] = {1.f / (s0.x + s1.x), 1.f / (s0.y + s1.y), 1.f / (s0.z + s1.z), 1.f / (s0.w + s1.w)};
#pragma unroll
      for (int ni = 0; ni < 4; ++ni)
#pragma unroll
        for (int q = 0; q < 4; ++q) {
          const int soff = ((wm * 64 + mi * 32 + 8 * g + q) * ld + col0 + wn * 128 + ni * 32) * 2;
          __builtin_amdgcn_raw_buffer_store_b16(f2bf(__expf(acc[mi][ni][4 * g + q] * rsf[mi][4 * g + q] - mx[q]) * inv[q]), rs, voff, soff, 0);
        }
    }
  LDS_BARRIER();
}

DEV void transpose_item(const float* W, int N, u16* WT, float* scr, int item, int nblk, int lane, bool inmap = false) {
  const int kb = item / nblk, nb = item % nblk, k0 = 64 * kb, n0 = 32 * nb;
  int ns = n0;
  if (inmap) {
    if (nb < 32) { const int q = nb & 7, c0 = (nb >> 3) * 128 + (q >> 2) * 64 + ((q & 3) >> 1) * 32; ns = (q & 1) ? 1024 + c0 : c0; }
    else if (nb < 48) ns = 512 + (nb - 32) * 32;
  }
  const int kq = lane >> 3, nq = (lane & 7) * 4;
  float4 v[8];
#pragma unroll
  for (int i = 0; i < 8; ++i) v[i] = (ns + nq < N) ? *(const float4*)(W + (size_t)(k0 + 8 * i + kq) * N + ns + nq) : make_float4(0.f, 0.f, 0.f, 0.f);
#pragma unroll
  for (int i = 0; i < 8; ++i) { float* d = scr + (8 * i + kq) * 33 + nq; d[0] = v[i].x; d[1] = v[i].y; d[2] = v[i].z; d[3] = v[i].w; }
  const int c = lane & 7;
#pragma unroll
  for (int j = 0; j < 4; ++j) {
    const int nn = (lane >> 3) + 8 * j; const float* s = scr + (8 * c) * 33 + nn;
    uint4 o; o.x = pk2(s[0 * 33], s[1 * 33]); o.y = pk2(s[2 * 33], s[3 * 33]); o.z = pk2(s[4 * 33], s[5 * 33]); o.w = pk2(s[6 * 33], s[7 * 33]);
    const int n = n0 + nn;
    const size_t off = (n < (N & ~255)) ? ((size_t)((n >> 8) * 16 + (k0 >> 6)) * 16384 + (size_t)(n & 255) * 64 + 8 * c) : ((size_t)n * 1024 + k0 + 8 * c);
    *(uint4*)(WT + off) = o;
  }
}

DEV void fold_item(const float* W, const float* SK, u16* WT, float* scr, int item, int lane) {
  const int kb = item >> 6, nb = item & 63, k0 = 64 * kb, n0 = 32 * nb;
  const int kq = lane >> 3, nq = (lane & 7) * 4;
  const int blk = n0 >> 7, key0 = (n0 & 127) + nq;
  const float* wp = W + (size_t)(k0 + kq) * 2048 + blk * 128;
  const float* sp = SK + ((size_t)blk * 128 + key0) * 128;
  float o[8][4];
#pragma unroll
  for (int i = 0; i < 8; ++i)
#pragma unroll
    for (int e = 0; e < 4; ++e) o[i][e] = 0.f;
#pragma unroll 2
  for (int c4 = 0; c4 < 32; ++c4) {
    float4 wv[8], sv[4];
#pragma unroll
    for (int i = 0; i < 8; ++i) wv[i] = *(const float4*)(wp + (size_t)(8 * i) * 2048 + 4 * c4);
#pragma unroll
    for (int e = 0; e < 4; ++e) sv[e] = *(const float4*)(sp + e * 128 + 4 * c4);
#pragma unroll
    for (int i = 0; i < 8; ++i)
#pragma unroll
      for (int e = 0; e < 4; ++e) o[i][e] += (wv[i].x * sv[e].x + wv[i].y * sv[e].y) + (wv[i].z * sv[e].z + wv[i].w * sv[e].w);
  }
#pragma unroll
  for (int i = 0; i < 8; ++i) { float* d = scr + (8 * i + kq) * 33 + nq; d[0] = o[i][0]; d[1] = o[i][1]; d[2] = o[i][2]; d[3] = o[i][3]; }
  const int c = lane & 7;
#pragma unroll
  for (int j = 0; j < 4; ++j) {
    const int nn = (lane >> 3) + 8 * j; const float* s = scr + (8 * c) * 33 + nn;
    uint4 ov; ov.x = pk2(s[0 * 33], s[1 * 33]); ov.y = pk2(s[2 * 33], s[3 * 33]); ov.z = pk2(s[4 * 33], s[5 * 33]); ov.w = pk2(s[6 * 33], s[7 * 33]);
    const int n = n0 + nn;
    *(uint4*)(WT + (size_t)((n >> 8) * 16 + kb) * 16384 + (size_t)(n & 255) * 64 + 8 * c) = ov;
  }
}

DEV void phase0(const Params& p, unsigned char* lds) {
  const int tid = opaque_tid(), lane = tid & 63, wave = tid >> 6;
  const int gw = blockIdx.x * 8 + wave, NGW = gridDim.x * 8;
  float* scr = (float*)(lds + wave * 8704);
  unsigned char* ws = p.ws;
  constexpr int I_IN = 16 * 113, I_SQ = 16 * 32, I_PQ = 16 * 64;
  constexpr int IPL = I_IN + 5 * I_SQ + I_PQ;
  for (int it = gw; it < 2 * IPL; it += NGW) {
    const int l = it / IPL; int r = it % IPL;
    if (r < I_IN) { transpose_item(p.w_in + (size_t)l * 1024 * 3592, 3592, (u16*)(ws + WS_WT_IN + l * SZ_WT_IN1), scr, r, 113, lane, true); continue; } r -= I_IN;
    if (r < I_SQ) { transpose_item(p.w_out + (size_t)l * DM * DM, 1024, (u16*)(ws + WS_WT_OUT + l * 2 * MiB), scr, r, 32, lane); continue; } r -= I_SQ;
    if (r < I_SQ) {
      const float4* s4 = (const float4*)(p.w_xq + (size_t)l * DM * DM) + (size_t)r * 512 + lane;
      uint2* d2 = (uint2*)(ws + WS_WT_XQ + l * 2 * MiB) + (size_t)r * 512 + lane;
#pragma unroll
      for (int i = 0; i < 8; ++i) { const float gk = p.g_xattn[l * DM + 2 * r + (i >> 2)];
        const float4 f = s4[64 * i]; d2[64 * i] = make_uint2(pk2(f.x * gk, f.y * gk), pk2(f.z * gk, f.w * gk)); }
      continue; } r -= I_SQ;
    if (r < I_SQ) { transpose_item(p.w_xk + (size_t)l * DM * DM, 1024, (u16*)(ws + WS_WT_XK + l * 2 * MiB), scr, r, 32, lane); continue; } r -= I_SQ;
    if (r < I_SQ) { transpose_item(p.w_xv + (size_t)l * DM * DM, 1024, (u16*)(ws + WS_WT_XV + l * 2 * MiB), scr, r, 32, lane); continue; } r -= I_SQ;
    if (r < I_SQ) { transpose_item(p.w_xo + (size_t)l * DM * DM, 1024, (u16*)(ws + WS_WT_XO + l * 2 * MiB), scr, r, 32, lane); continue; } r -= I_SQ;
    fold_item(p.w_pq + (size_t)l * DM * 2048, p.sub_keys + (size_t)l * 16 * 128 * 128, (u16*)(ws + WS_WT_PQ + l * 4 * MiB), scr, r, lane);
  }
  {
    unsigned char* e6 = ws + WS_EXP6;
    const int hl = lane & 31, q = hl & 15, c0 = 2 * (hl >> 4);
    for (int rp = gw; rp < 2 * NEXP; rp += NGW) {
      const int row = rp * 2 + (lane >> 5);
      const int l = row >> 15, uv = (row >> 14) & 1, e = row & (NEXP - 1);
      const float* srcp = (uv ? p.v_exp : p.u_exp) + ((size_t)l * NEXP + e) * DM;
      const float scl = uv ? 6.f : 48.f;
      f32x16 fa, fb;
#pragma unroll
      for (int j = 0; j < 8; ++j) {
        float4 f = ((const float4*)srcp)[64 * (c0 + (j >> 2)) + q + 16 * (j & 3)];
        f.x = fminf(fmaxf(f.x * scl, -7.5f), 7.5f); f.y = fminf(fmaxf(f.y * scl, -7.5f), 7.5f);
        f.z = fminf(fmaxf(f.z * scl, -7.5f), 7.5f); f.w = fminf(fmaxf(f.w * scl, -7.5f), 7.5f);
        fa[2 * j] = f.x; fb[2 * j] = f.y; fa[2 * j + 1] = f.z; fb[2 * j + 1] = f.w;
      }
      const u32x6 o = __builtin_amdgcn_cvt_scalef32_2xpk16_fp6_f32(fa, fb, 1.0f);
      unsigned char* dst = e6 + (size_t)(l * 2 + uv) * NEXP * 768 + ((size_t)c0 * NEXP + e) * 192 + q * 12;
      *(unsigned*)(dst) = o[0]; *(unsigned*)(dst + 4) = o[1]; *(unsigned*)(dst + 8) = o[2];
      dst += (size_t)NEXP * 192;
      *(unsigned*)(dst) = o[3]; *(unsigned*)(dst + 4) = o[4]; *(unsigned*)(dst + 8) = o[5];
    }
  }
  for (int row = gw; row < 1024; row += NGW) {
    const int l = row >> 9, r = row & 511;
    const float4* xr = (const float4*)(p.mem + (size_t)r * DM) + lane;
    float4 v[4]; float ss = 0.f;
#pragma unroll
    for (int j = 0; j < 4; ++j) { v[j] = xr[64 * j]; ss += v[j].x * v[j].x + v[j].y * v[j].y + v[j].z * v[j].z + v[j].w * v[j].w; }
    ss = wave_sum(ss);
    const float rs = rsqrtf(ss * (1.f / DM) + EPS);
    const float4* gr = (const float4*)(p.g_mem + l * DM) + lane;
    uint2* o = (uint2*)((u16*)(ws + WS_MEMN) + (size_t)row * DM) + lane;
#pragma unroll
    for (int j = 0; j < 4; ++j) { float4 gg = gr[64 * j]; o[64 * j] = make_uint2(pk2(v[j].x * rs * gg.x, v[j].y * rs * gg.y), pk2(v[j].z * rs * gg.z, v[j].w * rs * gg.w)); }
  }
}

DEV void memkv_job(const Params& p, unsigned char* lds, int job) {
  unsigned char* ws = opaque_ptr(p.ws);
  const int l = job >> 5, kv = (job >> 4) & 1, rt = (job >> 2) & 3, nt = job & 3;
  const u16* A = (const u16*)(ws + WS_MEMN) + ((size_t)l * 512 + rt * 128) * DM;
  const u16* B = (const u16*)(ws + (kv ? WS_WT_XV : WS_WT_XK) + l * 2 * MiB) + (size_t)nt * 256 * DM;
  u16* memk = (u16*)(ws + WS_MEMK) + ((size_t)l * 512 + rt * 128) * DM;
  u16* memv = (u16*)(ws + WS_MEMVT) + ((size_t)l * 512 + rt * 128) * DM;
  gemm_run<16>(lds, 1,
    [=](int) { TileDesc d; d.A = A; d.lda = DM; d.B = B; d.ldb = 64; d.kb = 16384; return d; },
    [=](int, const f32x16 (&acc)[2][4], int wm, int wn, int lane) { epi_store_bf16(acc, wm, wn, lane, kv ? memv : memk, DM, nt * 256, 1.f); });
}

DEV void foldq_job(const Params& p, unsigned char* lds, int job) {
  unsigned char* ws = opaque_ptr(p.ws);
  const int l = job >> 5, b = (job >> 4) & 1, h = (job >> 2) & 3, mt = (job >> 1) & 1, kh = job & 1;
  const u16* A = (const u16*)(ws + WS_MEMK) + ((size_t)l * 512 + b * 256 + mt * 128) * DM + h * 256;
  const u16* wq = (const u16*)(ws + WS_WT_XQ + l * 2 * MiB) + h * 256;
  u16* mq = (u16*)(ws + WS_WT_MQ) + (size_t)(l * 2 + b) * 1024 * 1024;
  gemm_run<4>(lds, 2,
    [=](int j) { TileDesc d; d.A = A; d.lda = DM; d.B = wq + (size_t)(kh * 2 + j) * 256 * DM; d.ldb = DM; d.kb = 64; return d; },
    [=](int j, const f32x16 (&acc)[2][4], int wm, int wn, int lane) { epi_store_tiled(acc, wm, wn, lane, mq, h, mt * 128, (kh * 2 + j) * 256, 0.0625f); });
}

DEV void foldv_job(const Params& p, unsigned char* lds, int job) {
  unsigned char* ws = opaque_ptr(p.ws);
  const int l = job >> 5, b = (job >> 4) & 1, h = (job >> 2) & 3, mt = (job >> 1) & 1, nh = job & 1;
  const u16* A = (const u16*)(ws + WS_MEMVT) + ((size_t)l * 512 + b * 256 + mt * 128) * DM + h * 256;
  const u16* wt = (const u16*)(ws + WS_WT_XO + l * 2 * MiB) + (size_t)(4 * h) * 16384;
  u16* mo = (u16*)(ws + WS_WT_MO) + (size_t)(l * 2 + b) * 1024 * 1024;
  gemm_run<4>(lds, 2,
    [=](int j) { TileDesc d; d.A = A; d.lda = DM; d.B = wt + (size_t)(nh * 2 + j) * 256 * DM; d.ldb = 64; d.kb = 16384; return d; },
    [=](int j, const f32x16 (&acc)[2][4], int wm, int wn, int lane) { epi_store_tiledT(acc, wm, wn, lane, mo, nh * 2 + j, h * 256 + mt * 128); });
}

constexpr int P272 = 272;
DEV void stage_rows256(unsigned char* dst, const u16* src, int stride_elems) {
  const int tid = opaque_tid();
  const int row = tid >> 4, cc = tid & 15;
  const u16* p0 = src + (size_t)row * stride_elems + cc * 8;
  const uint4 a0 = *(const uint4*)(p0), a1 = *(const uint4*)(p0 + (size_t)32 * stride_elems), a2 = *(const uint4*)(p0 + (size_t)64 * stride_elems), a3 = *(const uint4*)(p0 + (size_t)96 * stride_elems);
  const int o = row * P272 + cc * 16;
  *(uint4*)(dst + o) = a0; *(uint4*)(dst + o + 32 * P272) = a1; *(uint4*)(dst + o + 64 * P272) = a2; *(uint4*)(dst + o + 96 * P272) = a3;
}
DEV void stage_rows256x3(unsigned char* d0, const u16* s0, int st0, unsigned char* d1, const u16* s1, int st1, unsigned char* d2, const u16* s2, int st2) {
  const int tid = opaque_tid();
  const int row = tid >> 4, cc = tid & 15;
  const u16* p0 = s0 + (size_t)row * st0 + cc * 8; const u16* p1 = s1 + (size_t)row * st1 + cc * 8; const u16* p2 = s2 + (size_t)row * st2 + cc * 8;
  const uint4 a0 = *(const uint4*)(p0), a1 = *(const uint4*)(p0 + (size_t)32 * st0), a2 = *(const uint4*)(p0 + (size_t)64 * st0), a3 = *(const uint4*)(p0 + (size_t)96 * st0);
  const uint4 b0 = *(const uint4*)(p1), b1 = *(const uint4*)(p1 + (size_t)32 * st1), b2 = *(const uint4*)(p1 + (size_t)64 * st1), b3 = *(const uint4*)(p1 + (size_t)96 * st1);
  const uint4 c0 = *(const uint4*)(p2), c1 = *(const uint4*)(p2 + (size_t)32 * st2), c2 = *(const uint4*)(p2 + (size_t)64 * st2), c3 = *(const uint4*)(p2 + (size_t)96 * st2);
  const int o = row * P272 + cc * 16;
  *(uint4*)(d0 + o) = a0; *(uint4*)(d0 + o + 32 * P272) = a1; *(uint4*)(d0 + o + 64 * P272) = a2; *(uint4*)(d0 + o + 96 * P272) = a3;
  *(uint4*)(d1 + o) = b0; *(uint4*)(d1 + o + 32 * P272) = b1; *(uint4*)(d1 + o + 64 * P272) = b2; *(uint4*)(d1 + o + 96 * P272) = b3;
  *(uint4*)(d2 + o) = c0; *(uint4*)(d2 + o + 32 * P272) = c1; *(uint4*)(d2 + o + 64 * P272) = c2; *(uint4*)(d2 + o + 96 * P272) = c3;
}

DEV void phaseA_tile(const Params& p, unsigned char* lds, int l_in, int tile_in) {
  int l = __builtin_amdgcn_readfirstlane(l_in), tile = __builtin_amdgcn_readfirstlane(tile_in);
  asm volatile("" : "+s"(l), "+s"(tile));
  unsigned char* ws = opaque_ptr(p.ws);
  const int tid = opaque_tid(), lane = tid & 63, wave = tid >> 6;
  const u16* hbuf = (const u16*)(ws + WS_KVLOC + (size_t)tile * 256 * 1024);
  u16* z = (u16*)(ws + WS_Z) + (size_t)tile * 128 * NIN;
  u16* kT = (u16*)(ws + WS_KT) + (size_t)tile * 4 * 16384;
  u16* vT = (u16*)(ws + WS_VT) + (size_t)tile * 4 * 16384;
  const u16* wt_in = (const u16*)(ws + WS_WT_IN + l * SZ_WT_IN1);
  float* gates = (float*)(ws + WS_GATES) + (size_t)tile * 128 * 8;

  gemm_run<16>(lds, 14,
    [=](int j) { TileDesc d; d.A = hbuf; d.lda = DM; d.B = wt_in + (size_t)j * 256 * DM; d.ldb = 64; d.kb = 16384; return d; },
    [=](int j, const f32x16 (&acc)[2][4], int wm, int wn, int ln) {
      if (j < 4) epi_store_u(acc, wm, wn, ln, z, NIN, j * 128);
      else if (j < 6) epi_store_bf16(acc, wm, wn, ln, z, NIN, 512 + (j - 4) * 256, 1.f);
      else if (j != 10 && j != 11) epi_store_bf16(acc, wm, wn, ln, z, NIN, j * 256, 1.f);
      if (j == 8 || j == 9) epi_store_bf16_T(acc, wm, wn, ln, kT, 128, (j - 8) * 256);
      if (j == 10 || j == 11) epi_store_bf16_T(acc, wm, wn, ln, vT, 128, (j - 10) * 256);
    });

  {
    const int w4 = wave & 3, kh = wave >> 2;
    f32x16 acc = zero16();
    const u16* arow = hbuf + (size_t)(w4 * 32 + (lane & 31)) * DM + kh * 512 + (lane >> 5) * 8;
    const u16* brow = wt_in + (size_t)(NIN + (lane & 31)) * DM + kh * 512 + (lane >> 5) * 8;
#pragma unroll 8
    for (int ks = 0; ks < 32; ++ks) acc = __builtin_amdgcn_mfma_f32_32x32x16_bf16(ld_frag_g(arow + ks * 16), ld_frag_g(brow + ks * 16), acc, 0, 0, 0);
    const int col = lane & 31;
    float* gx = (float*)lds + (w4 * 64 + (lane >> 5) * 8 + col) * 16;
    if (kh == 1 && col < 8) {
#pragma unroll
      for (int r = 0; r < 16; r += 4) *(float4*)(gx + r) = make_float4(acc[r], acc[r + 1], acc[r + 2], acc[r + 3]);
    }
    __syncthreads();
    if (kh == 0 && col < 8) {
      const float bias = p.b_if[l * 8 + col];
#pragma unroll
      for (int r = 0; r < 16; ++r) gates[(size_t)(w4 * 32 + rowmap(r, lane)) * 8 + col] = acc[r] + gx[r] + bias;
    }
  }
  {
    float* halo = (float*)(ws + WS_HALO) + ((size_t)(l * 256 + tile) * 2) * 512;
    __syncthreads();
    const int c = tid;
#pragma unroll
    for (int tt = 0; tt < 2; ++tt) {
      const size_t r = (size_t)(126 + tt) * NIN;
      halo[tt * 512 + c] = bf2f(z[r + c]);
    }
  }
  __syncthreads();
  float* kw = (float*)(lds + 2 * 34816);
  if (wave < 4) {
    const int h = wave;
    const int s0 = 2 * lane, s1 = s0 + 1;
    const float f0 = gates[s0 * 8 + 4 + h], f1 = gates[s1 * 8 + 4 + h];
    const float i0 = gates[s0 * 8 + h], i1 = gates[s1 * 8 + h];
    const float ls0 = fminf(f0, 0.f) - log1pf(__expf(-fabsf(f0))), ls1 = fminf(f1, 0.f) - log1pf(__expf(-fabsf(f1)));
    const float pr = ls0 + ls1;
    float inc = pr;
#pragma unroll
    for (int o = 1; o < 64; o <<= 1) { const float t = shfl_idx(inc, lane >= o ? lane - o : lane); if (lane >= o) inc += t; }
    const float b0 = (inc - pr) + ls0, b1 = b0 + ls1;
    const float bL = __builtin_bit_cast(float, __builtin_amdgcn_readlane(__builtin_bit_cast(int, inc), 63));
    const float g0 = bL - b0 + i0, g1 = bL - b1 + i1;
    const float ml = wave_max(fmaxf(g0, g1));
    const float sc = 0.08838834764831845f;
    kw[h * 128 + s0] = __expf(g0 - ml) * sc; kw[h * 128 + s1] = __expf(g1 - ml) * sc;
    float* bcum = (float*)(ws + WS_BCUM) + ((size_t)tile * 4 + h) * 128;
    bcum[s0] = b0; bcum[s1] = b1;
    if (lane == 0) { ((float*)(ws + WS_MLOC))[tile * 4 + h] = ml; ((float*)(ws + WS_BL))[tile * 4 + h] = bL; }
  }
  __syncthreads();
  float* kvloc = (float*)(ws + WS_KVLOC) + (size_t)tile * 4 * 16384;
  float* nloc = (float*)(ws + WS_NLOC) + (size_t)tile * 4 * 128;
  for (int h = 0; h < 4; ++h) {
    unsigned char* VTl = lds; unsigned char* KWl = lds + 34816;
    uint4 kreg[4];
#pragma unroll
    for (int i = 0; i < 4; ++i) { const int c = tid + i * NT, row = c >> 4, cc = c & 15; kreg[i] = *(const uint4*)(kT + h * 16384 + (size_t)row * 128 + cc * 8); }
    stage_rows256(VTl, vT + h * 16384, 128);
#pragma unroll
    for (int i = 0; i < 4; ++i) {
      const int c = tid + i * NT, row = c >> 4, cc = c & 15;
      const uint4 v = kreg[i];
      const float* kwp = kw + h * 128 + cc * 8;
      const float e0 = bflo(v.x) * kwp[0], e1 = bfhi(v.x) * kwp[1], e2 = bflo(v.y) * kwp[2], e3 = bfhi(v.y) * kwp[3];
      const float e4 = bflo(v.z) * kwp[4], e5 = bfhi(v.z) * kwp[5], e6 = bflo(v.w) * kwp[6], e7 = bfhi(v.w) * kwp[7];
      uint4 o; o.x = pk2(e0, e1); o.y = pk2(e2, e3); o.z = pk2(e4, e5); o.w = pk2(e6, e7);
      *(uint4*)(KWl + row * P272 + cc * 16) = o;
      float sm = ((e0 + e1) + (e2 + e3)) + ((e4 + e5) + (e6 + e7));
      sm += shx<1>(sm); sm += shx<2>(sm); sm += shx<4>(sm); sm += shx<8>(sm);
      if (cc == 0) nloc[h * 128 + row] = sm;
    }
    __syncthreads();
    {
      const int tr = wave >> 1, tc0 = (wave & 1) * 2;
      f32x16 a0 = zero16(), a1 = zero16();
      const unsigned char* ap = VTl + (tr * 32 + (lane & 31)) * P272 + (lane >> 5) * 16;
      const unsigned char* bp = KWl + (tc0 * 32 + (lane & 31)) * P272 + (lane >> 5) * 16;
#pragma unroll
      for (int ks = 0; ks < 8; ++ks) {
        const bf16x8 a = ld_frag(ap + ks * 32);
        a0 = __builtin_amdgcn_mfma_f32_32x32x16_bf16(a, ld_frag(bp + ks * 32), a0, 0, 0, 0);
        a1 = __builtin_amdgcn_mfma_f32_32x32x16_bf16(a, ld_frag(bp + 32 * P272 + ks * 32), a1, 0, 0, 0);
      }
      float* dst = kvloc + h * 16384;
#pragma unroll
      for (int r = 0; r < 16; ++r) {
        const int v = tr * 32 + rowmap(r, lane);
        dst[v * 128 + tc0 * 32 + (lane & 31)] = a0[r];
        dst[v * 128 + (tc0 + 1) * 32 + (lane & 31)] = a1[r];
      }
    }
    __syncthreads();
  }
}

DEV void phaseB(const Params& p, unsigned char* lds) {
  unsigned char* ws = opaque_ptr(p.ws);
  const int tid = opaque_tid();
  float* wd = (float*)lds; float* wl = wd + 128; float* mst = wl + 128; float* blv = mst + 128; float* mlv = blv + 128;
  for (int vb = blockIdx.x; vb < 256; vb += gridDim.x) {
    const int bh = vb >> 5, b = bh >> 2, h = bh & 3;
    const int e = (vb & 31) * 512 + tid;
    __syncthreads();
    if (tid < 128) { const int tile = b * 128 + tid; blv[tid] = ((const float*)(ws + WS_BL))[tile * 4 + h]; mlv[tid] = ((const float*)(ws + WS_MLOC))[tile * 4 + h]; }
    __syncthreads();
    if (tid == 0) {
      float m = 0.f;
      for (int c = 0; c < 128; ++c) {
        const float bl = blv[c], ml = mlv[c];
        const float mn = fmaxf(bl + m, ml);
        wd[c] = __expf(bl + m - mn); wl[c] = __expf(ml - mn); mst[c] = m; m = mn;
      }
    }
    __syncthreads();
    const float* kv = (const float*)(ws + WS_KVLOC) + ((size_t)(b * 128) * 4 + h) * 16384 + e;
    u16* cs = (u16*)(ws + WS_CSTATE) + ((size_t)(b * 128) * 4 + h) * 16384 + e;
    float C = 0.f;
#pragma unroll 1
    for (int c0 = 0; c0 < 128; c0 += 32) {
      float v[32];
#pragma unroll
      for (int q = 0; q < 32; ++q) v[q] = kv[(size_t)(c0 + q) * 4 * 16384];
#pragma unroll
      for (int q = 0; q < 32; ++q) {
        cs[(size_t)(c0 + q) * 4 * 16384] = f2bf(C);
        C = wd[c0 + q] * C + wl[c0 + q] * v[q];
      }
    }
    if ((vb & 31) == 0 && tid < 128) {
      const float* nl = (const float*)(ws + WS_NLOC) + ((size_t)(b * 128) * 4 + h) * 128 + tid;
      float* ns = (float*)(ws + WS_NSTATE) + ((size_t)(b * 128) * 4 + h) * 128 + tid;
      float n = 0.f;
      for (int c = 0; c < 128; ++c) { ns[(size_t)c * 512] = n; n = wd[c] * n + wl[c] * nl[(size_t)c * 512]; }
      ((float*)(ws + WS_MSTATE))[(b * 128 + tid) * 4 + h] = mst[tid];
    }
  }
}

DEV float erf_as(float x) {
  const float ax = fabsf(x);
  const float t = __builtin_amdgcn_rcpf(1.f + 0.3275911f * ax);
  const float poly = ((((1.061405429f * t - 1.453152027f) * t + 1.421413741f) * t - 0.284496736f) * t + 0.254829592f) * t;
  const float y = 1.f - poly * __expf(-ax * ax);
  return copysignf(y, x);
}
DEV unsigned ordkey(float f) { const unsigned u = __float_as_uint(f); return (u & 0x80000000u) ? ~u : (u | 0x80000000u); }
DEV float unordkey(unsigned k) { return (k & 0x80000000u) ? __uint_as_float(k & 0x7fffffffu) : __uint_as_float(~k); }
#define CE_DESC(a, b) { const unsigned hi__ = max(a, b), lo__ = min(a, b); a = hi__; b = lo__; }
DEV void sort16_desc(unsigned (&a)[16]) {
#pragma unroll
  for (int k = 2; k <= 16; k <<= 1) {
#pragma unroll
    for (int j = k >> 1; j > 0; j >>= 1) {
#pragma unroll
      for (int i = 0; i < 16; ++i) {
        const int l = i ^ j;
        if (l > i) {
          if ((i & k) == 0 || k == 16) { CE_DESC(a[i], a[l]); } else { CE_DESC(a[l], a[i]); }
        }
      }
    }
  }
}
DEV void merge16_desc(unsigned (&a)[16]) {
#pragma unroll
  for (int j = 8; j > 0; j >>= 1) {
#pragma unroll
    for (int i = 0; i < 16; ++i) { const int l = i ^ j; if (l > i) { CE_DESC(a[i], a[l]); } }
  }
}
#define INSERT16(list, key_)                                                         \
  {                                                                                  \
    unsigned kx_ = (key_);                                                           \
    _Pragma("unroll") for (int q_ = 0; q_ < 16; ++q_) {                              \
      const unsigned hi_ = max(list[q_], kx_); kx_ = min(list[q_], kx_); list[q_] = hi_; \
    }                                                                                \
  }

DEV void epi_topk1(const f32x16 (&acc)[2][4], int wm, int wn, int lane, int hh, const float* rsv, unsigned* topG) {
  const int tl = lane & 31, h = lane >> 5;
#pragma unroll
  for (int mi = 0; mi < 2; ++mi) {
    const int row = wm * 64 + mi * 32 + tl;
    const float rs = rsv[row];
    unsigned L[16];
#pragma unroll
    for (int ni = 0; ni < 4; ++ni) {
      unsigned B[16];
#pragma unroll
      for (int r = 0; r < 16; ++r) B[r] = (ordkey(acc[mi][ni][r] * rs) & ~127u) | (unsigned)(127 - (ni * 32 + 8 * (r >> 2) + 4 * h + (r & 3)));
      sort16_desc(B);
      if (ni == 0) {
#pragma unroll
        for (int i = 0; i < 16; ++i) L[i] = B[i];
      } else {
#pragma unroll
        for (int i = 0; i < 16; ++i) L[i] = max(L[i], B[15 - i]);
        merge16_desc(L);
      }
    }
    unsigned P[16];
#pragma unroll
    for (int i = 0; i < 16; ++i) P[i] = (unsigned)__builtin_amdgcn_ds_bpermute((lane ^ 32) << 2, (int)L[i]);
#pragma unroll
    for (int i = 0; i < 16; ++i) L[i] = max(L[i], P[15 - i]);
    merge16_desc(L);
    if (h == 0) {
      uint4* tp = (uint4*)(topG + ((size_t)(hh * 2 + wn) * 128 + row) * 16);
      tp[0] = make_uint4(L[0], L[1], L[2], L[3]); tp[1] = make_uint4(L[4], L[5], L[6], L[7]);
      tp[2] = make_uint4(L[8], L[9], L[10], L[11]); tp[3] = make_uint4(L[12], L[13], L[14], L[15]);
    }
  }
}
DEV void topk_stage2(const unsigned* topG, int t, int hh, unsigned char* R4) {
  unsigned L0[16], L1[16];
  {
    const uint4* p0 = (const uint4*)(topG + ((size_t)(hh * 2 + 0) * 128 + t) * 16); const uint4* p1 = (const uint4*)(topG + ((size_t)(hh * 2 + 1) * 128 + t) * 16);
#pragma unroll
    for (int q = 0; q < 4; ++q) {
      const uint4 a = p0[q], b = p1[q];
      L0[4 * q] = a.x; L0[4 * q + 1] = a.y; L0[4 * q + 2] = a.z; L0[4 * q + 3] = a.w;
      L1[4 * q] = b.x; L1[4 * q + 1] = b.y; L1[4 * q + 2] = b.z; L1[4 * q + 3] = b.w;
    }
  }
  float v0[16], v1[16];
#pragma unroll
  for (int i = 0; i < 16; ++i) { v0[i] = unordkey(L0[i] & ~127u); v1[i] = unordkey(L1[i] & ~127u); }
#define PK_KEY(i_, j_) ((ordkey(v0[i_] + v1[j_]) & ~255u) | (unsigned)(255 - ((i_) * 16 + (j_))))
  unsigned L2[16], A1[16], B0[16], B1[16];
#pragma unroll
  for (int j = 0; j < 16; ++j) L2[j] = PK_KEY(0, j);
#pragma unroll
  for (int j = 0; j < 8; ++j) { A1[j] = PK_KEY(1, j); A1[8 + j] = 0u; }
#pragma unroll
  for (int i = 0; i < 16; ++i) L2[i] = max(L2[i], A1[15 - i]);
  merge16_desc(L2);
  B0[0] = PK_KEY(2, 0); B0[1] = PK_KEY(2, 1); B0[2] = PK_KEY(2, 2); B0[3] = PK_KEY(2, 3); B0[4] = PK_KEY(2, 4);
  B0[5] = PK_KEY(3, 0); B0[6] = PK_KEY(3, 1); B0[7] = PK_KEY(3, 2); B0[8] = PK_KEY(3, 3);
  B0[9] = PK_KEY(4, 0); B0[10] = PK_KEY(4, 1); B0[11] = PK_KEY(4, 2);
  B0[12] = PK_KEY(5, 0); B0[13] = PK_KEY(5, 1); B0[14] = PK_KEY(6, 0); B0[15] = PK_KEY(6, 1);
  B1[0] = PK_KEY(7, 0); B1[1] = PK_KEY(7, 1);
#pragma unroll
  for (int i = 8; i < 16; ++i) B1[i - 6] = PK_KEY(i, 0);
#pragma unroll
  for (int i = 10; i < 16; ++i) B1[i] = 0u;
  sort16_desc(B0); sort16_desc(B1);
#pragma unroll
  for (int i = 0; i < 16; ++i) B0[i] = max(B0[i], B1[15 - i]);
  merge16_desc(B0);
#pragma unroll
  for (int i = 0; i < 16; ++i) L2[i] = max(L2[i], B0[15 - i]);
  merge16_desc(L2);
#undef PK_KEY
  float fv[16]; int eid[16];
  unsigned p0[4], p1[4];
#pragma unroll
  for (int w = 0; w < 4; ++w) {
    p0[w] = (127u - (L0[4 * w] & 127u)) | ((127u - (L0[4 * w + 1] & 127u)) << 8) | ((127u - (L0[4 * w + 2] & 127u)) << 16) | ((127u - (L0[4 * w + 3] & 127u)) << 24);
    p1[w] = (127u - (L1[4 * w] & 127u)) | ((127u - (L1[4 * w + 1] & 127u)) << 8) | ((127u - (L1[4 * w + 2] & 127u)) << 16) | ((127u - (L1[4 * w + 3] & 127u)) << 24);
  }
#pragma unroll
  for (int k = 0; k < 16; ++k) {
    fv[k] = unordkey(L2[k] & ~255u);
    const unsigned c = 255u - (L2[k] & 255u), ci = c >> 4, cj = c & 15u;
    const unsigned a_lo = (ci & 8u) ? p0[2] : p0[0], a_hi = (ci & 8u) ? p0[3] : p0[1];
    const unsigned b_lo = (cj & 8u) ? p1[2] : p1[0], b_hi = (cj & 8u) ? p1[3] : p1[1];
    const unsigned i0 = __builtin_amdgcn_perm(a_hi, a_lo, 0x0c0c0c00u | (ci & 7u));
    const unsigned i1 = __builtin_amdgcn_perm(b_hi, b_lo, 0x0c0c0c00u | (cj & 7u));
    eid[k] = (int)(i0 * 128u + i1);
  }
  float sum = 0.f;
  const float fmx = fv[0];
#pragma unroll
  for (int k = 0; k < 16; ++k) { fv[k] = __expf(fv[k] - fmx); sum += fv[k]; }
  const float inv = 1.f / sum;
  int* eo = (int*)(R4 + (size_t)t * 1024) + hh * 16;
  float* go = (float*)(R4 + (size_t)t * 1024 + 512) + hh * 16;
#pragma unroll
  for (int k = 0; k < 16; k += 4) {
    *(int4*)(eo + k) = make_int4(eid[k], eid[k + 1], eid[k + 2], eid[k + 3]);
    *(float4*)(go + k) = make_float4(fv[k] * inv, fv[k + 1] * inv, fv[k + 2] * inv, fv[k + 3] * inv);
  }
}

DEV void phaseC_tile(const Params& p, unsigned char* lds, int l_in, int tile_in, bool last) {
  int l = __builtin_amdgcn_readfirstlane(l_in), tile = __builtin_amdgcn_readfirstlane(tile_in);
  asm volatile("" : "+s"(l), "+s"(tile));
  unsigned char* ws = opaque_ptr(p.ws);
  const int tid = opaque_tid(), lane = tid & 63, wave = tid >> 6;
  const int bidx = tile >> 7;
  u16* z = (u16*)(ws + WS_Z) + (size_t)tile * 128 * NIN;
  unsigned char* zslot = ws + WS_Z + (size_t)tile * ZSLOT;
  u16* R1 = (u16*)(ws + WS_KVLOC + (size_t)tile * 256 * 1024);
  u16* R2 = (u16*)(zslot + R2_OFF);
  unsigned char* R3 = zslot + R3_OFF;
  unsigned char* R4 = zslot + R4_OFF;
  u16* xs = (u16*)(p.out + (size_t)tile * 128 * DM + 65536);
  const void* xsrc = (l == 0) ? (const void*)(p.x + (size_t)tile * 128 * DM) : (const void*)xs;
  const float* gates = (const float*)(ws + WS_GATES) + (size_t)tile * 128 * 8;

  {
    unsigned char* KPl = lds; unsigned char* VTl = lds + 34816; unsigned char* CTl = lds + 69632;
    float* sm = (float*)(lds + 104448);
    float* avs = sm; float* Mt = sm + 128; float* iwv = sm + 256; float* emt = sm + 384; float* nrm = sm + 512; float* nst = sm + 640;
    float* HL = (float*)VTl;
    const int rb = wave >> 1, half = wave & 1;
    for (int h = 0; h < 4; ++h) {
      stage_rows256x3(KPl, z + 2048 + h * 128, NIN, VTl, (const u16*)(ws + WS_VT) + ((size_t)tile * 4 + h) * 16384, 128, CTl, (const u16*)(ws + WS_CSTATE) + ((size_t)tile * 4 + h) * 16384, 128);
      const float mprev = ((const float*)(ws + WS_MSTATE))[tile * 4 + h];
      if (wave == 0) {
        const int s0 = 2 * lane, s1 = s0 + 1;
        const float* bc = (const float*)(ws + WS_BCUM) + ((size_t)tile * 4 + h) * 128;
        const float b0 = bc[s0], b1 = bc[s1];
        const float a0 = gates[s0 * 8 + h] - b0, a1 = gates[s1 * 8 + h] - b1;
        float v = fmaxf(a0, a1);
#pragma unroll
        for (int o = 1; o < 64; o <<= 1) { const float t = shfl_idx(v, lane >= o ? lane - o : lane); if (lane >= o) v = fmaxf(v, t); }
        float ex = shfl_idx(v, lane >= 1 ? lane - 1 : lane); if (lane == 0) ex = -INFINITY;
        const float A0 = fmaxf(ex, a0), A1 = fmaxf(A0, a1);
        const float M0 = fmaxf(mprev, A0), M1 = fmaxf(mprev, A1);
        avs[s0] = a0; avs[s1] = a1; Mt[s0] = M0; Mt[s1] = M1;
        iwv[s0] = __expf(mprev - M0); iwv[s1] = __expf(mprev - M1);
        emt[s0] = __expf(-b0 - M0); emt[s1] = __expf(-b1 - M1);
      } else if (wave == 1) {
        const float* ns = (const float*)(ws + WS_NSTATE) + ((size_t)tile * 4 + h) * 128;
        nst[lane] = ns[lane]; nst[lane + 64] = ns[lane + 64];
      }
      bf16x8 qf[8];
      {
        const u16* qrow = z + (size_t)(rb * 32 + (lane & 31)) * NIN + 1536 + h * 128 + (lane >> 5) * 8;
#pragma unroll
        for (int ks = 0; ks < 8; ++ks) qf[ks] = ld_frag_g(qrow + ks * 16);
      }
      __syncthreads();
      f32x16 s0a = zero16(), s1a = zero16();
      {
        const unsigned char* bp = KPl + (half * 64 + (lane & 31)) * P272 + (lane >> 5) * 16;
#pragma unroll
        for (int ks = 0; ks < 8; ++ks) {
          s0a = __builtin_amdgcn_mfma_f32_32x32x16_bf16(qf[ks], ld_frag(bp + ks * 32), s0a, 0, 0, 0);
          s1a = __builtin_amdgcn_mfma_f32_32x32x16_bf16(qf[ks], ld_frag(bp + 32 * P272 + ks * 32), s1a, 0, 0, 0);
        }
      }
      {
        const float sc = 0.08838834764831845f;
        const int sA = half * 64 + (lane & 31), sB = sA + 32;
        const float avA = avs[sA], avB = avs[sB];
#pragma unroll
        for (int g = 0; g < 4; ++g) {
          const int t0 = rb * 32 + 8 * g + 4 * (lane >> 5);
          const float4 m4 = *(const float4*)(Mt + t0);
          const float mm[4] = {m4.x, m4.y, m4.z, m4.w};
#pragma unroll
          for (int e = 0; e < 4; ++e) {
            const int t = t0 + e;
            s0a[4 * g + e] = (sA <= t) ? s0a[4 * g + e] * sc * __expf(avA - mm[e]) : 0.f;
            s1a[4 * g + e] = (sB <= t) ? s1a[4 * g + e] * sc * __expf(avB - mm[e]) : 0.f;
          }
        }
      }
      __syncthreads();
      {
        u16* P = (u16*)KPl;
        const int sA = half * 64 + (lane & 31), sB = sA + 32;
#pragma unroll
        for (int r = 0; r < 16; ++r) {
          const int t = rb * 32 + rowmap(r, lane);
          P[t * (P272 / 2) + sA] = f2bf(s0a[r]);
          P[t * (P272 / 2) + sB] = f2bf(s1a[r]);
        }
      }
      __syncthreads();
      {
        const int t = tid >> 2, qd = tid & 3;
        const unsigned char* pr = KPl + t * P272 + qd * 64;
        float rs = 0.f;
#pragma unroll
        for (int i = 0; i < 4; ++i) { const uint4 v = *(const uint4*)(pr + i * 16); rs += (bflo(v.x) + bfhi(v.x)) + (bflo(v.y) + bfhi(v.y)) + (bflo(v.z) + bfhi(v.z)) + (bflo(v.w) + bfhi(v.w)); }
        const u16* qr = z + (size_t)t * NIN + 1536 + h * 128 + qd * 32;
        const float* nn = nst + qd * 32;
        float qn = 0.f;
#pragma unroll
        for (int i = 0; i < 4; ++i) {
          const uint4 v = *(const uint4*)(qr + i * 8);
          qn += bflo(v.x) * nn[i * 8 + 0] + bfhi(v.x) * nn[i * 8 + 1] + bflo(v.y) * nn[i * 8 + 2] + bfhi(v.y) * nn[i * 8 + 3] +
                bflo(v.z) * nn[i * 8 + 4] + bfhi(v.z) * nn[i * 8 + 5] + bflo(v.w) * nn[i * 8 + 6] + bfhi(v.w) * nn[i * 8 + 7];
        }
        rs += shx<1>(rs); rs += shx<2>(rs);
        qn += shx<1>(qn); qn += shx<2>(qn);
        const float den = rs + iwv[t] * qn;
        if (qd == 0) nrm[t] = 1.f / fmaxf(fabsf(den), emt[t]);
      }
      f32x16 n0 = zero16(), n1 = zero16(), c0 = zero16(), c1 = zero16();
      {
        const unsigned char* ap = KPl + (rb * 32 + (lane & 31)) * P272 + (lane >> 5) * 16;
        const unsigned char* vp = VTl + (half * 64 + (lane & 31)) * P272 + (lane >> 5) * 16;
        const unsigned char* cp = CTl + (half * 64 + (lane & 31)) * P272 + (lane >> 5) * 16;
#pragma unroll
        for (int ks = 0; ks < 8; ++ks) {
          const bf16x8 a = ld_frag(ap + ks * 32);
          n0 = __builtin_amdgcn_mfma_f32_32x32x16_bf16(a, ld_frag(vp + ks * 32), n0, 0, 0, 0);
          n1 = __builtin_amdgcn_mfma_f32_32x32x16_bf16(a, ld_frag(vp + 32 * P272 + ks * 32), n1, 0, 0, 0);
          c0 = __builtin_amdgcn_mfma_f32_32x32x16_bf16(qf[ks], ld_frag(cp + ks * 32), c0, 0, 0, 0);
          c1 = __builtin_amdgcn_mfma_f32_32x32x16_bf16(qf[ks], ld_frag(cp + 32 * P272 + ks * 32), c1, 0, 0, 0);
        }
      }
      __syncthreads();
      {
        const int vA = half * 64 + (lane & 31), vB = vA + 32;
#pragma unroll
        for (int g = 0; g < 4; ++g) {
          const int t0 = rb * 32 + 8 * g + 4 * (lane >> 5);
          const float4 iw4 = *(const float4*)(iwv + t0), nr4 = *(const float4*)(nrm + t0);
          const float iw[4] = {iw4.x, iw4.y, iw4.z, iw4.w}, nr[4] = {nr4.x, nr4.y, nr4.z, nr4.w};
#pragma unroll
          for (int e = 0; e < 4; ++e) {
            const int t = t0 + e;
            const float hA = (n0[4 * g + e] + iw[e] * c0[4 * g + e]) * nr[e];
            const float hB = (n1[4 * g + e] + iw[e] * c1[4 * g + e]) * nr[e];
            const float oA = bf2f(z[(size_t)t * NIN + 3072 + h * 128 + vA]), oB = bf2f(z[(size_t)t * NIN + 3072 + h * 128 + vB]);
            HL[t * 132 + vA] = hA / (1.f + __expf(-oA));
            HL[t * 132 + vB] = hB / (1.f + __expf(-oB));
          }
        }
      }
      __syncthreads();
      {
        const int t = tid >> 2, qd = tid & 3;
        const float* hr = HL + t * 132 + qd * 32;
        float v[32]; float ss = 0.f;
#pragma unroll
        for (int i = 0; i < 8; ++i) { const float4 f = *(const float4*)(hr + i * 4); v[4 * i] = f.x; v[4 * i + 1] = f.y; v[4 * i + 2] = f.z; v[4 * i + 3] = f.w; ss += f.x * f.x + f.y * f.y + f.z * f.z + f.w * f.w; }
        ss += shx<1>(ss); ss += shx<2>(ss);
        const float r = rsqrtf(ss * (1.f / 128.f) + EPS);
        const float* gh = p.g_head + l * 512 + h * 128 + qd * 32;
        u16* yo = R1 + (size_t)t * DM + 512 + h * 128 + qd * 32;
#pragma unroll
        for (int i = 0; i < 4; ++i) {
          uint4 o;
          o.x = pk2(v[8 * i + 0] * r * gh[8 * i + 0], v[8 * i + 1] * r * gh[8 * i + 1]);
          o.y = pk2(v[8 * i + 2] * r * gh[8 * i + 2], v[8 * i + 3] * r * gh[8 * i + 3]);
          o.z = pk2(v[8 * i + 4] * r * gh[8 * i + 4], v[8 * i + 5] * r * gh[8 * i + 5]);
          o.w = pk2(v[8 * i + 6] * r * gh[8 * i + 6], v[8 * i + 7] * r * gh[8 * i + 7]);
          *(uint4*)(yo + i * 8) = o;
        }
      }
      __syncthreads();
    }
  }
  {
    const int c = (tid & 255) * 2, th = tid >> 8, t0 = th * 64;
    const float2 w0 = *(const float2*)(p.conv_w + (l * 3 + 0) * 512 + c), w1 = *(const float2*)(p.conv_w + (l * 3 + 1) * 512 + c), w2 = *(const float2*)(p.conv_w + (l * 3 + 2) * 512 + c);
    const float2 cb = *(const float2*)(p.conv_b + l * 512 + c);
    float2 um2 = make_float2(0.f, 0.f), um1 = make_float2(0.f, 0.f);
    if (th == 1) {
      const unsigned xa = *(const unsigned*)(z + (size_t)62 * NIN + c), xb = *(const unsigned*)(z + (size_t)63 * NIN + c);
      um2 = make_float2(bflo(xa), bfhi(xa)); um1 = make_float2(bflo(xb), bfhi(xb));
    } else if ((tile & 127) != 0) {
      const float* halo = (const float*)(ws + WS_HALO) + ((size_t)(l * 256 + tile - 1) * 2) * 512;
      um2 = *(const float2*)(halo + c); um1 = *(const float2*)(halo + 512 + c);
    }
#pragma unroll 1
    for (int tb = t0; tb < t0 + 64; tb += 8) {
      unsigned xw[8], bw[8];
#pragma unroll
      for (int q = 0; q < 8; ++q) { const size_t r = (size_t)(tb + q) * NIN; xw[q] = *(const unsigned*)(z + r + c); bw[q] = *(const unsigned*)(z + r + 512 + c); }
#pragma unroll
      for (int q = 0; q < 8; ++q) {
        const float2 u = make_float2(bflo(xw[q]), bfhi(xw[q]));
        const float y0 = bflo(bw[q]) * (w0.x * um2.x + w1.x * um1.x + w2.x * u.x + cb.x);
        const float y1 = bfhi(bw[q]) * (w0.y * um2.y + w1.y * um1.y + w2.y * u.y + cb.y);
        *(unsigned*)(R1 + (size_t)(tb + q) * DM + c) = pk2(y0, y1);
        um2 = um1; um1 = u;
      }
    }
  }
  __syncthreads();
  float* rowss = (float*)(lds + 110592 + 1024); float* rsv = (float*)(lds + 110592);
  {
    const u16* wt = (const u16*)(ws + WS_WT_OUT + l * 2 * MiB);
    const float* gx = p.g_xattn + l * DM;
    u16* xg = (u16*)R3;
    gemm_run<16>(lds, 4,
      [=](int j) { TileDesc d; d.A = R1; d.lda = DM; d.B = wt + (size_t)j * 256 * DM; d.ldb = 64; d.kb = 16384; return d; },
      [=](int j, const f32x16 (&acc)[2][4], int wm, int wn, int ln) { epi_residual_norm(acc, wm, wn, ln, xsrc, l == 0, xs, j * 256, gx, (u16*)nullptr, rowss); });
    if (tid < 128) { float s_ = 0.f;
#pragma unroll
      for (int q = 0; q < 8; ++q) s_ += rowss[q * 128 + tid];
      rsv[tid] = rsqrtf(s_ * (1.f / DM) + EPS); }
  }
  {
    const u16* wt = (const u16*)(ws + WS_WT_MQ) + (size_t)(l * 2 + bidx) * 1024 * 1024;
    const u16* xg = xs;
    float* pm = (float*)(lds + 110592 + 1024); float* ps = pm + 256;
    gemm_run<16, 3>(lds, 4,
      [=](int j) { TileDesc d; d.A = xg; d.lda = DM; d.B = wt + (size_t)j * 256 * DM; d.ldb = 64; d.kb = 16384; return d; },
      [=](int j, const f32x16 (&acc)[2][4], int wm, int wn, int ln) { epi_softmax_bf16(acc, wm, wn, ln, R2, DM, j * 256, rsv, pm, ps); });
  }
  {
    const u16* wt = (const u16*)(ws + WS_WT_MO) + (size_t)(l * 2 + bidx) * 1024 * 1024;
    const u16* ao = (const u16*)R2;
    const float* gf = p.g_ffn + l * DM;
    gemm_run<16>(lds, 4,
      [=](int j) { TileDesc d; d.A = ao; d.lda = DM; d.B = wt + (size_t)j * 256 * DM; d.ldb = 64; d.kb = 16384; return d; },
      [=](int j, const f32x16 (&acc)[2][4], int wm, int wn, int ln) { epi_residual_norm(acc, wm, wn, ln, xs, false, xs, j * 256, gf, R1, rowss); });
    if (tid < 128) { float s_ = 0.f;
#pragma unroll
      for (int q = 0; q < 8; ++q) s_ += rowss[q * 128 + tid];
      rsv[tid] = rsqrtf(s_ * (1.f / DM) + EPS); }
  }
  {
    const u16* wt = (const u16*)(ws + WS_WT_PQ + l * 4 * MiB);
    unsigned* topG = (unsigned*)R3;
    gemm_run<16, 0, true>(lds, 8,
      [=](int j) { TileDesc d; d.A = R1; d.lda = DM; d.B = wt + (size_t)j * 256 * DM; d.ldb = 64; d.kb = 16384; return d; },
      [=](int j, const f32x16 (&acc)[2][4], int wm, int wn, int ln) { epi_topk1(acc, wm, wn, ln, j, rsv, topG); });
#pragma unroll 1
    for (int it = 0; it < 2; ++it) topk_stage2(topG, tid & 127, (tid >> 7) + 4 * it, R4);
    __syncthreads();
  }
}

DEV void grid_barrier(cg::grid_group& grid) {
  asm volatile("s_waitcnt vmcnt(0)" ::: "memory");
  __syncthreads();
  grid.sync();
  __builtin_amdgcn_fence(__ATOMIC_ACQUIRE, "agent");
  asm volatile("s_waitcnt vmcnt(0)" ::: "memory");
  __syncthreads();
}
DEV void grid_barrier_ctr(unsigned* ctr, unsigned target) {
  asm volatile("s_waitcnt vmcnt(0)" ::: "memory");
  __syncthreads();
  if (threadIdx.x == 0) {
    __builtin_amdgcn_fence(__ATOMIC_RELEASE, "agent");
    asm volatile("s_waitcnt vmcnt(0)" ::: "memory");
    __hip_atomic_fetch_add(ctr, 1u, __ATOMIC_RELAXED, __HIP_MEMORY_SCOPE_AGENT);
    while (__hip_atomic_load(ctr, __ATOMIC_RELAXED, __HIP_MEMORY_SCOPE_AGENT) < target) __builtin_amdgcn_s_sleep(2);
  }
  __syncthreads();
  __builtin_amdgcn_fence(__ATOMIC_ACQUIRE, "agent");
  asm volatile("s_waitcnt vmcnt(0)" ::: "memory");
  __syncthreads();
}

DEV void peer_gather(const Params& p, unsigned char* lds, int l_in, int tile_in, bool last, bool active, unsigned* bar, unsigned& nbar) {
  int l = __builtin_amdgcn_readfirstlane(l_in), tile = __builtin_amdgcn_readfirstlane(tile_in);
  asm volatile("" : "+s"(l), "+s"(tile));
  unsigned char* ws = opaque_ptr(p.ws);
  const int tid = opaque_tid(), lane = tid & 63, wave = __builtin_amdgcn_readfirstlane(tid >> 6);
  const int q = lane & 15, g4 = lane >> 4, q12 = q * 12;
  u16* R1 = (u16*)(ws + WS_KVLOC + (size_t)tile * 256 * 1024);
  unsigned char* R4 = ws + WS_Z + (size_t)tile * ZSLOT + R4_OFF;
  float* xout = p.out + (size_t)tile * 128 * DM;
  u16* xs = (u16*)(xout + 65536);
  int* eidL = (int*)lds;
  float* hacc = (float*)(lds + 65536);
  float* rsvG = (float*)(lds + 131072);
  float* ssq = rsvG + 128;
  const unsigned char* utab = ws + WS_EXP6 + (size_t)(l * 2 + 0) * NEXP * 768;
  const unsigned char* vtab = ws + WS_EXP6 + (size_t)(l * 2 + 1) * NEXP * 768;

  if (active) {
    const float* rsv = (const float*)(lds + 110592);
    float rv = 0.f;
    if (tid < 128) rv = rsv[tid];
    __syncthreads();
    if (tid < 128) rsvG[tid] = rv;
    {
      int ev[32];
#pragma unroll
      for (int i = 0; i < 16; ++i) {
        const int* eo = (const int*)(R4 + (size_t)(wave + 8 * i) * 1024);
        ev[2 * i] = eo[lane]; ev[2 * i + 1] = eo[lane + 64];
      }
#pragma unroll
      for (int i = 0; i < 16; ++i) {
        const int t = wave + 8 * i;
#pragma unroll
        for (int r = 0; r < 2; ++r) {
          const int sel = lane + 64 * r;
          eidL[t * 128 + (sel & 3) * 32 + 2 * (sel >> 3) + ((sel >> 2) & 1)] = ev[2 * i + r];
        }
      }
    }
    __syncthreads();
  }

#define SEG_LD(rsrc_, e_) __builtin_amdgcn_raw_buffer_load_b96(rsrc_, (int)(__umul24((unsigned)(e_), 192u) + (unsigned)q12), 0, 0)
#define LD_GROUP(S_, rsrc_, t_, G_) { const int4* ep_ = (const int4*)(eidL + (t_) * 128 + g4 * 32 + 16 * (G_)); \
    const int4 e0_ = ep_[0], e1_ = ep_[1], e2_ = ep_[2], e3_ = ep_[3]; \
    S_[0] = SEG_LD(rsrc_, e0_.x); S_[1] = SEG_LD(rsrc_, e0_.y); S_[2] = SEG_LD(rsrc_, e0_.z); S_[3] = SEG_LD(rsrc_, e0_.w); \
    S_[4] = SEG_LD(rsrc_, e1_.x); S_[5] = SEG_LD(rsrc_, e1_.y); S_[6] = SEG_LD(rsrc_, e1_.z); S_[7] = SEG_LD(rsrc_, e1_.w); \
    S_[8] = SEG_LD(rsrc_, e2_.x); S_[9] = SEG_LD(rsrc_, e2_.y); S_[10] = SEG_LD(rsrc_, e2_.z); S_[11] = SEG_LD(rsrc_, e2_.w); \
    S_[12] = SEG_LD(rsrc_, e3_.x); S_[13] = SEG_LD(rsrc_, e3_.y); S_[14] = SEG_LD(rsrc_, e3_.z); S_[15] = SEG_LD(rsrc_, e3_.w); }

#pragma unroll 1
  for (int c = 0; c < 4; ++c) {
    if (active) {
      const __amdgpu_buffer_rsrc_t rsrc = mkrsrc(utab + (size_t)c * NEXP * 192);
      u32x3 s0[16], s1[16];
      u32x2 hx[4];
      {
        const GAS u32x2* xrow = (const GAS u32x2*)(R1 + (size_t)wave * DM) + 64 * c + q;
#pragma unroll
        for (int j = 0; j < 4; ++j) hx[j] = xrow[16 * j];
        LD_GROUP(s0, rsrc, wave, 0);
      }
#pragma unroll 1
      for (int i = 0; i < 16; ++i) {
        const int t = wave + 8 * i, tn = wave + 8 * (i < 15 ? i + 1 : 15);
        float P[32];
        LD_GROUP(s1, rsrc, t, 1);
        u32x2 hxn[4];
        {
          const GAS u32x2* xrow = (const GAS u32x2*)(R1 + (size_t)tn * DM) + 64 * c + q;
#pragma unroll
          for (int j = 0; j < 4; ++j) hxn[j] = xrow[16 * j];
        }
        const unsigned hvb[8] = {hx[0].x, hx[0].y, hx[1].x, hx[1].y, hx[2].x, hx[2].y, hx[3].x, hx[3].y};
#define U_PAIR(S_, pp_, base_) { \
          u32x6 w_ = (u32x6){S_[2 * (pp_)].x, S_[2 * (pp_)].y, S_[2 * (pp_)].z, S_[2 * (pp_) + 1].x, S_[2 * (pp_) + 1].y, S_[2 * (pp_) + 1].z}; \
          asm volatile("" : "+v"(w_));        \
          const bf16x32 uf = __builtin_amdgcn_cvt_scalef32_pk32_bf16_fp6(w_, 1.0f); \
          float sa = 0.f, sb = 0.f; \
          U_DOT(0) U_DOT(1) U_DOT(2) U_DOT(3) U_DOT(4) U_DOT(5) U_DOT(6) U_DOT(7) \
          P[(base_) + 2 * (pp_)] = sa; P[(base_) + 2 * (pp_) + 1] = sb; \
          __builtin_amdgcn_sched_barrier(0); }
#define U_DOT(I) sa = __builtin_amdgcn_fdot2_f32_bf16(__builtin_shufflevector(uf, uf, 2 * (I), 2 * (I) + 1), __builtin_bit_cast(bf16x2, hvb[I]), sa, false); \
                 sb = __builtin_amdgcn_fdot2_f32_bf16(__builtin_shufflevector(uf, uf, 16 + 2 * (I), 17 + 2 * (I)), __builtin_bit_cast(bf16x2, hvb[I]), sb, false);
        U_PAIR(s0, 0, 0) U_PAIR(s0, 1, 0) U_PAIR(s0, 2, 0) U_PAIR(s0, 3, 0) U_PAIR(s0, 4, 0) U_PAIR(s0, 5, 0) U_PAIR(s0, 6, 0) U_PAIR(s0, 7, 0)
        __builtin_amdgcn_sched_barrier(0);
        LD_GROUP(s0, rsrc, tn, 0);
        __builtin_amdgcn_sched_barrier(0);
        U_PAIR(s1, 0, 16) U_PAIR(s1, 1, 16) U_PAIR(s1, 2, 16) U_PAIR(s1, 3, 16) U_PAIR(s1, 4, 16) U_PAIR(s1, 5, 16) U_PAIR(s1, 6, 16) U_PAIR(s1, 7, 16)
#undef U_DOT
#undef U_PAIR
        {
          const bool b3 = (lane & 8) != 0, b2 = (lane & 4) != 0, b1 = (lane & 2) != 0, b0 = (lane & 1) != 0;
          float A8[16], A4[8], A2[4], A1[2];
#pragma unroll
          for (int n = 0; n < 16; ++n) { const float snd = b3 ? P[n] : P[n + 16], kp = b3 ? P[n + 16] : P[n]; A8[n] = kp + shx<8>(snd); }
#pragma unroll
          for (int n = 0; n < 8; ++n) { const float snd = b2 ? A8[n] : A8[n + 8], kp = b2 ? A8[n + 8] : A8[n]; A4[n] = kp + shx<4>(snd); }
#pragma unroll
          for (int n = 0; n < 4; ++n) { const float snd = b1 ? A4[n] : A4[n + 4], kp = b1 ? A4[n + 4] : A4[n]; A2[n] = kp + shx<2>(snd); }
#pragma unroll
          for (int n = 0; n < 2; ++n) { const float snd = b0 ? A2[n] : A2[n + 2], kp = b0 ? A2[n + 2] : A2[n]; A1[n] = kp + shx<1>(snd); }
          float2* hp = (float2*)(hacc + t * 128 + g4 * 32 + 2 * q);
          if (c == 0) *hp = make_float2(A1[0], A1[1]);
          else { const float2 o = *hp; *hp = make_float2(o.x + A1[0], o.y + A1[1]); }
        }
#pragma unroll
        for (int j = 0; j < 4; ++j) hx[j] = hxn[j];
      }
    }
  }
  if (active) {
    float gv[32];
#pragma unroll
    for (int i = 0; i < 16; ++i) {
      const float* go = (const float*)(R4 + (size_t)(wave + 8 * i) * 1024 + 512);
#pragma unroll
      for (int r = 0; r < 2; ++r) {
        const int pos = lane + 64 * r, w = pos & 31;
        gv[2 * i + r] = go[8 * (w >> 1) + 4 * (w & 1) + (pos >> 5)];
      }
    }
#pragma unroll
    for (int i = 0; i < 16; ++i) {
      const int t = wave + 8 * i;
      const float rs = rsvG[t];
#pragma unroll
      for (int r = 0; r < 2; ++r) {
        const int pos = lane + 64 * r;
        const float am = hacc[t * 128 + pos] * rs * (1.f / 48.f);
        hacc[t * 128 + pos] = gv[2 * i + r] * 0.5f * am * (1.f + erf_as(am * 0.7071067811865476f)) * (1.f / 6.f);
      }
    }
  }
#pragma unroll 1
  for (int c = 0; c < 4; ++c) {
    if (active) {
      const __amdgpu_buffer_rsrc_t rsrc = mkrsrc(vtab + (size_t)c * NEXP * 192);
      u32x3 s0[16], s1[16];
      LD_GROUP(s0, rsrc, wave, 0);
#pragma unroll 1
      for (int i = 0; i < 16; ++i) {
        const int t = wave + 8 * i, tn = wave + 8 * (i < 15 ? i + 1 : 15);
        LD_GROUP(s1, rsrc, t, 1);
        GAS u32x2* xp = (GAS u32x2*)(xs + (size_t)t * DM) + 64 * c + lane;
        const u32x2 xw = *xp;
        f32x4 xo = {bflo(xw.x), bfhi(xw.x), bflo(xw.y), bfhi(xw.y)};
        f32x16 ov;
#pragma unroll
        for (int k = 0; k < 16; ++k) ov[k] = 0.f;
#define V_PAIR(S_, pp_, cfa_, cfb_) { \
          u32x6 w_ = (u32x6){S_[2 * (pp_)].x, S_[2 * (pp_)].y, S_[2 * (pp_)].z, S_[2 * (pp_) + 1].x, S_[2 * (pp_) + 1].y, S_[2 * (pp_) + 1].z}; \
          asm volatile("" : "+v"(w_)); \
          const f32x32 vf = __builtin_amdgcn_cvt_scalef32_pk32_f32_fp6(w_, 1.0f); \
          ov += __builtin_shufflevector(vf, vf, 0, 1, 2, 3, 4, 5, 6, 7, 8, 9, 10, 11, 12, 13, 14, 15) * (cfa_); \
          ov += __builtin_shufflevector(vf, vf, 16, 17, 18, 19, 20, 21, 22, 23, 24, 25, 26, 27, 28, 29, 30, 31) * (cfb_); \
          __builtin_amdgcn_sched_barrier(0); }
        {
          const float4* cp = (const float4*)(hacc + t * 128 + g4 * 32);
          const float4 c0 = cp[0], c1 = cp[1], c2 = cp[2], c3 = cp[3];
          V_PAIR(s0, 0, c0.x, c0.y) V_PAIR(s0, 1, c0.z, c0.w) V_PAIR(s0, 2, c1.x, c1.y) V_PAIR(s0, 3, c1.z, c1.w)
          V_PAIR(s0, 4, c2.x, c2.y) V_PAIR(s0, 5, c2.z, c2.w) V_PAIR(s0, 6, c3.x, c3.y) V_PAIR(s0, 7, c3.z, c3.w)
        }
        __builtin_amdgcn_sched_barrier(0);
        LD_GROUP(s0, rsrc, tn, 0);
        __builtin_amdgcn_sched_barrier(0);
        {
          const float4* cp = (const float4*)(hacc + t * 128 + g4 * 32 + 16);
          const float4 c0 = cp[0], c1 = cp[1], c2 = cp[2], c3 = cp[3];
          V_PAIR(s1, 0, c0.x, c0.y) V_PAIR(s1, 1, c0.z, c0.w) V_PAIR(s1, 2, c1.x, c1.y) V_PAIR(s1, 3, c1.z, c1.w)
          V_PAIR(s1, 4, c2.x, c2.y) V_PAIR(s1, 5, c2.z, c2.w) V_PAIR(s1, 6, c3.x, c3.y) V_PAIR(s1, 7, c3.z, c3.w)
        }
#undef V_PAIR
        {
          const bool b5 = (lane & 32) != 0, b4 = (lane & 16) != 0;
          float B8[8], B4[4], os[16];
#pragma unroll
          for (int k = 0; k < 16; ++k) { os[k] = ov[k]; asm volatile("" : "+v"(os[k])); }
#pragma unroll
          for (int n = 0; n < 8; ++n) { const float snd = b5 ? os[n] : os[n + 8], kp = b5 ? os[n + 8] : os[n]; B8[n] = kp + shfl_idx(snd, lane ^ 32); }
#pragma unroll
          for (int n = 0; n < 4; ++n) { const float snd = b4 ? B8[n] : B8[n + 4], kp = b4 ? B8[n + 4] : B8[n]; B4[n] = kp + shx<16>(snd); }
          xo.x += B4[0]; xo.y += B4[1]; xo.z += B4[2]; xo.w += B4[3];
        }
        *xp = (u32x2){pk2(xo.x, xo.y), pk2(xo.z, xo.w)};
        const float sq = wave_sum(xo.x * xo.x + xo.y * xo.y + xo.z * xo.z + xo.w * xo.w);
        if (lane == 0) ssq[t] = (c == 0) ? sq : ssq[t] + sq;
      }
    }
  }
#undef LD_GROUP
#undef SEG_LD
  if (active) {
    float4 gg[4];
#pragma unroll
    for (int j = 0; j < 4; ++j) gg[j] = last ? ((const float4*)p.g_final)[lane + 64 * j] : ((const float4*)(p.g_mix + (l + 1) * DM))[lane + 64 * j];
#define FIN_LOAD(buf_, i_) { const uint2* xr_ = (const uint2*)(xs + (size_t)(wave + 8 * (i_)) * DM); _Pragma("unroll") for (int j = 0; j < 4; ++j) buf_[j] = xr_[lane + 64 * j]; }
#define FIN_STORE(buf_, i_) { const int t_ = wave + 8 * (i_); const float r3_ = rsqrtf(ssq[t_] * (1.f / DM) + EPS); \
      if (last) { float4* xw_ = (float4*)(xout + (size_t)t_ * DM); \
        _Pragma("unroll") for (int j = 0; j < 4; ++j) xw_[lane + 64 * j] = make_float4(bflo(buf_[j].x) * r3_ * gg[j].x, bfhi(buf_[j].x) * r3_ * gg[j].y, bflo(buf_[j].y) * r3_ * gg[j].z, bfhi(buf_[j].y) * r3_ * gg[j].w); } \
      else { uint2* ho_ = (uint2*)(R1 + (size_t)t_ * DM) + lane; \
        _Pragma("unroll") for (int j = 0; j < 4; ++j) ho_[64 * j] = make_uint2(pk2(bflo(buf_[j].x) * r3_ * gg[j].x, bfhi(buf_[j].x) * r3_ * gg[j].y), pk2(bflo(buf_[j].y) * r3_ * gg[j].z, bfhi(buf_[j].y) * r3_ * gg[j].w)); } }
    uint2 xa[4], xb[4];
    FIN_LOAD(xa, 0);
    const int nstream = last ? 8 : 16;
#pragma unroll 1
    for (int i = 0; i < nstream; i += 2) {
      FIN_LOAD(xb, i + 1);
      FIN_STORE(xa, i);
      if (i + 2 < nstream) FIN_LOAD(xa, i + 2);
      FIN_STORE(xb, i + 1);
    }
    if (last) {
      uint2 xr[8][4];
#pragma unroll
      for (int i = 0; i < 8; ++i) FIN_LOAD(xr[i], 8 + i);
      asm volatile("s_waitcnt vmcnt(0)" ::: "memory");
      __syncthreads();
#pragma unroll
      for (int i = 0; i < 8; ++i) FIN_STORE(xr[i], 8 + i);
    }
#undef FIN_LOAD
#undef FIN_STORE
  }
  __syncthreads();
}

__global__ void __launch_bounds__(NT) fwd_mega(Params p) {
  cg::grid_group grid = cg::this_grid();
  __shared__ __attribute__((aligned(16))) unsigned char lds[LDS_BYTES];
  unsigned char* ws = p.ws;

  phase0(p, lds);
  grid_barrier(grid);

  for (int job = blockIdx.x; job < 64; job += gridDim.x) memkv_job(p, lds, job);
  unsigned* bar = (unsigned*)(ws + WS_BAR);
  unsigned nbar = 0;
  const int iters = (NTILES + (int)gridDim.x - 1) / (int)gridDim.x;
#pragma unroll 1
  for (int st = 0; st < 3; ++st) {
#pragma unroll 1
    for (int it = 0; it < iters; ++it) {
      const int tile0 = (int)blockIdx.x + it * (int)gridDim.x;
      const bool act = tile0 < NTILES;
      const int tile = act ? tile0 : 0;
      if (st > 0) {
        if (act) phaseC_tile(p, lds, st - 1, tile, st == 2);
        peer_gather(p, lds, st - 1, tile, st == 2, act, bar, nbar);
      }
      if (act) {
        if (st == 0) rmsnorm_tile(p.x + (size_t)tile * 128 * DM, p.g_mix, (u16*)(ws + WS_KVLOC + (size_t)tile * 256 * 1024));
        if (st < 2) phaseA_tile(p, lds, st, tile);
      }
    }
    if (st < 2) {
      grid_barrier_ctr(bar, (unsigned)gridDim.x * (++nbar));
      if (st == 0) for (int job = blockIdx.x; job < 128; job += gridDim.x) { if (job < 64) foldv_job(p, lds, job); else foldq_job(p, lds, job - 64); }
      phaseB(p, lds);
      grid_barrier_ctr(bar, (unsigned)gridDim.x * (++nbar));
    }
  }
}

extern "C" void kernel_launch(void* const* d_in, const int* in_sizes, int n_in, void* d_out, int out_size, void* d_ws, size_t ws_size, hipStream_t stream) {
  static int grid_blocks = 0;
  if (!grid_blocks) {
    int dev = 0, cus = 0, per_cu = 0;
    (void)hipGetDevice(&dev);
    (void)hipDeviceGetAttribute(&cus, hipDeviceAttributeMultiprocessorCount, dev);
    (void)hipOccupancyMaxActiveBlocksPerMultiprocessor(&per_cu, fwd_mega, NT, 0);
    if (per_cu < 1) { fprintf(stderr, "kernel_launch: occupancy query says %d blocks/CU\n", per_cu); per_cu = 1; }
    grid_blocks = cus < NTILES ? cus : NTILES;
    if (ws_size < WS_END || n_in != 21 || out_size != NTOK * DM) { fprintf(stderr, "kernel_launch: bad sizes ws=%zu need=%zu n_in=%d out=%d\n", ws_size, (size_t)WS_END, n_in, out_size); grid_blocks = -1; }
  }
  if (grid_blocks < 0) return;
  Params p{};
  const float** pp = (const float**)&p;
  for (int i = 0; i < 21; ++i) pp[i] = (const float*)d_in[i];
  p.out = (float*)d_out; p.ws = (unsigned char*)d_ws;
  (void)hipMemsetAsync((unsigned char*)d_ws + WS_BAR, 0, 4096, stream);
  void* args[] = {&p};
  hipError_t e = hipLaunchCooperativeKernel((void*)fwd_mega, dim3(grid_blocks), dim3(NT), args, 0, stream);
  if (e != hipSuccess) fprintf(stderr, "cooperative launch failed: %s (grid %d)\n", hipGetErrorString(e), grid_blocks);
}
```
